# Optimizing an MI355X kernel written in HIP

```python
import math
import jax
import jax.numpy as jnp
from jax import lax
import numpy as np

D_MODEL = 1024
BATCH = 8
SEQ = 2048
DEPTH = 4
DEC_BATCH = 128
DEC_SEQ = 4
PAST_LEN = 16384
PAGE_SIZE = 128

N_META = 16
N_AB = (DEPTH + 1) // 2
N_C = DEPTH // 2

GLA_HEADS = 4
GLA_DK = D_MODEL // 4
GLA_DV = D_MODEL // 2
GLA_HK = GLA_DK // GLA_HEADS
GLA_HV = GLA_DV // GLA_HEADS
GLA_GATE_RANK = 16
GLA_GATE_NORM = 16.0
GLA_CHUNK = 16
GLA_COLS = 2 * GLA_DK + 2 * GLA_DV + GLA_GATE_RANK

RWKV_DIM = D_MODEL // 2
RWKV_HEAD = 64
RWKV_HEADS = RWKV_DIM // RWKV_HEAD
RWKV_DECAY_RANK = 64
RWKV_A_RANK = 64
RWKV_GATE_RANK = 128
RWKV_COLS = 3 * RWKV_DIM + RWKV_DECAY_RANK + RWKV_A_RANK + RWKV_GATE_RANK
RWKV_GN_EPS = 64e-5

AB_COLS = GLA_COLS + RWKV_COLS
AB_OUT = GLA_DV + RWKV_DIM

GDN_HEADS = 8
GDN_HEAD = 128
GDN_DIM = GDN_HEADS * GDN_HEAD
GDN_CONV = 4
GDN_CHUNK = 64
C_COLS = 4 * GDN_DIM + 2 * GDN_HEADS

D_FF = 2816
FFN_CONV = 3

LN_EPS = 1e-5
NORM_EPS = 1e-6
DEEPNORM_ALPHA = (2.0 * DEPTH) ** 0.25
DEEPNORM_BETA = (8.0 * DEPTH) ** -0.25

kernel_name = 'hybrid_gla_rwkv7_gdn_convffn_step'


def _split(t, sizes):
    offs, acc = [], 0
    for s in sizes[:-1]:
        acc += s
        offs.append(acc)
    return jnp.split(t, offs, axis=-1)


def _layer_norm(x, g, b):
    xf = x.astype(jnp.float32)
    mu = jnp.mean(xf, axis=-1, keepdims=True)
    var = jnp.mean(jnp.square(xf - mu), axis=-1, keepdims=True)
    y = (xf - mu) * lax.rsqrt(var + LN_EPS) * g.astype(jnp.float32) + b.astype(jnp.float32)
    return y.astype(x.dtype)


def _rms_norm(x, g):
    xf = x.astype(jnp.float32)
    return xf * lax.rsqrt(jnp.mean(jnp.square(xf), axis=-1, keepdims=True) + NORM_EPS) * g.astype(jnp.float32)


def _l2_normalize(x):
    xf = x.astype(jnp.float32)
    return xf * lax.rsqrt(jnp.sum(xf * xf, axis=-1, keepdims=True) + NORM_EPS)


def _causal_dwconv(u, buf, w):
    width = w.shape[0]
    T = u.shape[1]
    full = jnp.concatenate([buf.astype(u.dtype), u], axis=1)
    out = sum(full[:, j:j + T] * w[j] for j in range(width))
    return out, full[:, T:]


def _to_chunks(t, chunk):
    B, T, H, d = t.shape
    return t.reshape(B, T // chunk, chunk, H, d).transpose(1, 0, 3, 2, 4)


def _from_chunks(t):
    n, B, H, L, d = t.shape
    return t.transpose(1, 0, 3, 2, 4).reshape(B, n * L, H, d)


def _gla_chunked(q, k, v, log_a, s0, chunk):
    f32 = jnp.float32
    qc, kc, vc, gc = (_to_chunks(t.astype(f32), chunk) for t in (q, k, v, log_a))
    causal = jnp.tril(jnp.ones((chunk, chunk), bool))

    def step(s, inp):
        qi, ki, vi, gi = inp
        b = jnp.cumsum(gi, axis=-2)
        qd = qi * jnp.exp(b)
        kd = ki * jnp.exp(-b)
        att = jnp.where(causal, jnp.einsum('bhld,bhmd->bhlm', qd, kd), 0.0)
        o = jnp.einsum('bhld,bhdv->bhlv', qd, s) + jnp.einsum('bhlm,bhmv->bhlv', att, vi)
        b_end = b[..., -1:, :]
        s = s * jnp.exp(b_end)[..., 0, :, None] + jnp.einsum('bhld,bhlv->bhdv', ki * jnp.exp(b_end - b), vi)
        return s, o

    s, o = lax.scan(step, s0.astype(f32), (qc, kc, vc, gc))
    return _from_chunks(o), s


def _gated_delta_chunked(q, k, v, beta, g, s0, chunk):
    f32 = jnp.float32
    dv = v.shape[-1]
    qc, kc, vc = (_to_chunks(t.astype(f32), chunk) for t in (q, k, v))
    bc = _to_chunks(beta.astype(f32)[..., None], chunk)[..., 0]
    gc = _to_chunks(g.astype(f32)[..., None], chunk)[..., 0]
    incl = jnp.tril(jnp.ones((chunk, chunk), bool))
    strict = jnp.tril(jnp.ones((chunk, chunk), bool), -1)
    eye = jnp.eye(chunk, dtype=f32)

    def step(s, inp):
        qi, ki, vi, bi, gi = inp
        gam = jnp.cumsum(gi, axis=-1)
        dec = jnp.exp(jnp.where(incl, gam[..., :, None] - gam[..., None, :], -jnp.inf))
        a_mat = jnp.where(strict, jnp.einsum('bhlk,bhmk->bhlm', ki, ki) * dec, 0.0) * bi[..., :, None] + eye
        rhs = jnp.concatenate([vi * bi[..., None], ki * (bi * jnp.exp(gam))[..., None]], axis=-1)
        sol = lax.linalg.triangular_solve(a_mat, rhs, left_side=True, lower=True, unit_diagonal=True)
        u, w = sol[..., :dv], sol[..., dv:]
        delta = u - jnp.einsum('bhlk,bhkv->bhlv', w, s)
        qk = jnp.einsum('bhlk,bhmk->bhlm', qi, ki) * dec
        o = jnp.einsum('bhlk,bhkv->bhlv', qi * jnp.exp(gam)[..., None], s) + jnp.einsum('bhlm,bhmv->bhlv', qk, delta)
        g_end = gam[..., -1:]
        s = s * jnp.exp(g_end)[..., None] + jnp.einsum('bhlk,bhlv->bhkv', ki * jnp.exp(g_end - gam)[..., None], delta)
        return s, o

    s, o = lax.scan(step, s0.astype(f32), (qc, kc, vc, bc, gc))
    return _from_chunks(o), s


def _rwkv7_scan(r, decay, k, v, a, b, s0):
    def step(s, inp):
        rt, wt, kt, vt, at, bt = inp
        sa = jnp.einsum('bhvk,bhk->bhv', s, at)
        s = s * wt[:, :, None, :] + sa[..., None] * bt[:, :, None, :] + vt[..., None] * kt[:, :, None, :]
        return s, jnp.einsum('bhvk,bhk->bhv', s, rt)

    xs = tuple(jnp.moveaxis(t, 1, 0) for t in (r, decay, k, v, a, b))
    s, y = lax.scan(step, s0.astype(jnp.float32), xs)
    return jnp.moveaxis(y, 0, 1), s


def _ab_mixer(x, x_last, s_gla, s_rwkv, p, i, gla_chunk):
    f32 = jnp.float32
    B, T, _ = x.shape
    w_in = p['w_in_ab'][i]
    z = x @ w_in
    z_gla, z_rwkv = z[..., :GLA_COLS], z[..., GLA_COLS:]
    q, k, v, g_lo, og = _split(z_gla, (GLA_DK, GLA_DK, GLA_DV, GLA_GATE_RANK, GLA_DV))
    log_a = jax.nn.log_sigmoid((g_lo @ p['gla_gate_w2'][i] + p['gla_gate_b'][i]).astype(f32)) / GLA_GATE_NORM
    heads_k = lambda t: t.astype(f32).reshape(B, T, GLA_HEADS, GLA_HK)
    o_gla, s_gla_new = _gla_chunked(heads_k(q) * GLA_HK ** -0.5, heads_k(k),
                                    v.astype(f32).reshape(B, T, GLA_HEADS, GLA_HV), heads_k(log_a),
                                    s_gla, gla_chunk)
    o_gla = _rms_norm(o_gla, p['gla_norm_g'][i].reshape(GLA_HEADS, GLA_HV)).reshape(B, T, GLA_DV) * jax.nn.silu(og.astype(f32))
    prev_first = x_last @ w_in[:, GLA_COLS:]
    z_prev = jnp.concatenate([prev_first[:, None].astype(z.dtype), z_rwkv[:, :-1]], axis=1)
    z_rwkv = z_rwkv + p['rwkv_mu'][i] * (z_prev - z_rwkv)
    r, kr, vr, w_lo, a_lo, g_lo2 = _split(z_rwkv.astype(f32), (RWKV_DIM, RWKV_DIM, RWKV_DIM, RWKV_DECAY_RANK, RWKV_A_RANK, RWKV_GATE_RANK))
    w_raw = p['rwkv_w0'][i] + jnp.tanh(w_lo) @ p['rwkv_w2'][i]
    decay = jnp.exp(-jnp.exp(-jax.nn.softplus(-w_raw) - 0.5))
    a_lr = jax.nn.sigmoid(p['rwkv_a0'][i] + a_lo @ p['rwkv_a2'][i])
    gate = jax.nn.sigmoid(g_lo2) @ p['rwkv_g2'][i]
    heads = lambda t: t.reshape(B, T, RWKV_HEADS, RWKV_HEAD)
    kk = _l2_normalize(heads(kr * p['rwkv_k_k'][i]))
    k_mod = kr * (1.0 + (a_lr - 1.0) * p['rwkv_k_a'][i])
    y, s_rwkv_new = _rwkv7_scan(heads(r), heads(decay), heads(k_mod), heads(vr), -kk, kk * heads(a_lr), s_rwkv)
    mu = jnp.mean(y, axis=-1, keepdims=True)
    var = jnp.mean(jnp.square(y - mu), axis=-1, keepdims=True)
    y = ((y - mu) * lax.rsqrt(var + RWKV_GN_EPS)).reshape(B, T, RWKV_DIM) * p['rwkv_ln_g'][i] + p['rwkv_ln_b'][i]
    bonus = jnp.sum(heads(r) * heads(k_mod) * p['rwkv_r_k'][i], axis=-1, keepdims=True) * heads(vr)
    y = (y + bonus.reshape(B, T, RWKV_DIM)) * gate
    mix = jnp.concatenate([o_gla, y], axis=-1).astype(x.dtype) @ p['w_out_ab'][i]
    return mix, s_gla_new, s_rwkv_new, x[:, -1]


def _c_mixer(x, conv_buf, s, p, i, segments):
    f32 = jnp.float32
    B, T, _ = x.shape
    z = x @ p['w_in_c'][i]
    qkv, zg, b_lo, a_lo = _split(z, (3 * GDN_DIM, GDN_DIM, GDN_HEADS, GDN_HEADS))
    qkv, new_buf = _causal_dwconv(qkv, conv_buf, p['gdn_conv_w'][i])
    qkv = jax.nn.silu(qkv.astype(f32))
    q, k, v = (t.reshape(B, T, GDN_HEADS, GDN_HEAD) for t in jnp.split(qkv, 3, axis=-1))
    q = _l2_normalize(q) * GDN_HEAD ** -0.5
    k = _l2_normalize(k)
    beta = jax.nn.sigmoid(b_lo.astype(f32))
    g = -jnp.exp(p['gdn_A_log'][i].astype(f32)) * jax.nn.softplus(a_lo.astype(f32) + p['gdn_dt_bias'][i])
    outs = []
    for start, end, chunk in segments:
        o, s = _gated_delta_chunked(q[:, start:end], k[:, start:end], v[:, start:end],
                                    beta[:, start:end], g[:, start:end], s, chunk)
        outs.append(o)
    o = jnp.concatenate(outs, axis=1)
    o = _rms_norm(o, p['gdn_norm_g'][i]).reshape(B, T, GDN_DIM) * jax.nn.silu(zg.astype(f32))
    return o.astype(x.dtype) @ p['w_out_c'][i], new_buf, s


def _conv_ffn(x, buf, p, l):
    h = x @ p['w_up'][l]
    gate, up = jnp.split(h, [D_FF], axis=-1)
    gate, new_buf = _causal_dwconv(gate, buf, p['ffn_conv_w'][l])
    return (jax.nn.silu(gate + p['ffn_conv_b'][l]) * up) @ p['w_down'][l], new_buf


def _trunk(x, st_gla, st_rwkv, st_shift, st_gdn, st_gdn_conv, st_ffn_conv, p, n_lead):
    T = x.shape[1]
    if n_lead > 0:
        segments = ((0, n_lead, n_lead), (n_lead, T, math.gcd(T - n_lead, GDN_CHUNK)))
    else:
        segments = ((0, T, math.gcd(T, GDN_CHUNK)),)
    gla_chunk = math.gcd(T, GLA_CHUNK)
    new_gla, new_rwkv, new_shift, new_gdn, new_gdn_conv, new_ffn_conv = [], [], [], [], [], []
    for l in range(DEPTH):
        i = l // 2
        if l % 2 == 0:
            mix, s_g, s_r, s_sh = _ab_mixer(x, st_shift[i], st_gla[i], st_rwkv[i], p, i, gla_chunk)
            new_gla.append(s_g.astype(st_gla.dtype))
            new_rwkv.append(s_r.astype(st_rwkv.dtype))
            new_shift.append(s_sh.astype(st_shift.dtype))
        else:
            mix, c_buf, s_d = _c_mixer(x, st_gdn_conv[i], st_gdn[i], p, i, segments)
            new_gdn_conv.append(c_buf.astype(st_gdn_conv.dtype))
            new_gdn.append(s_d.astype(st_gdn.dtype))
        x = _layer_norm(DEEPNORM_ALPHA * x + mix, p['ln_mix_g'][l], p['ln_mix_b'][l])
        f, f_buf = _conv_ffn(x, st_ffn_conv[l], p, l)
        new_ffn_conv.append(f_buf.astype(st_ffn_conv.dtype))
        x = _layer_norm(DEEPNORM_ALPHA * x + f, p['ln_ffn_g'][l], p['ln_ffn_b'][l])
    return (x, jnp.stack(new_gla), jnp.stack(new_rwkv), jnp.stack(new_shift),
            jnp.stack(new_gdn), jnp.stack(new_gdn_conv), jnp.stack(new_ffn_conv))


def setup_inputs(seed: int = 0) -> dict:
    key = jax.random.key(seed)
    ks = iter(jax.random.split(key, 64))
    f32 = jnp.float32
    nrm = lambda shape, std: std * jax.random.normal(next(ks), shape, f32)
    ones_n = lambda shape: 1.0 + nrm(shape, 0.02)
    beta = DEEPNORM_BETA
    ratio = jnp.linspace(0.0, 1.0, RWKV_DIM, dtype=f32)
    w0 = (-6.0 + 5.0 * ratio ** 1.5 + 0.5)[None] + nrm((N_AB, RWKV_DIM), 0.1)
    dt = jnp.exp(jax.random.uniform(next(ks), (N_C, GDN_HEADS), f32, math.log(1e-3), math.log(1e-1)))
    dt_bias = dt + jnp.log(-jnp.expm1(-dt))
    a_log = jnp.log(jax.random.uniform(next(ks), (N_C, GDN_HEADS), f32, 1.0, 16.0))
    return {
        'x_prompt': nrm((BATCH, SEQ, D_MODEL), 1.0),
        'x_sample': nrm((DEC_BATCH, DEC_SEQ, D_MODEL), 1.0),
        'state_gla': nrm((N_AB, DEC_BATCH, GLA_HEADS, GLA_HK, GLA_HV), 0.5),
        'state_rwkv': nrm((N_AB, DEC_BATCH, RWKV_HEADS, RWKV_HEAD, RWKV_HEAD), 0.5),
        'state_rwkv_shift': nrm((N_AB, DEC_BATCH, D_MODEL), 1.0),
        'state_gdn': nrm((N_C, DEC_BATCH, GDN_HEADS, GDN_HEAD, GDN_HEAD), 0.1),
        'state_gdn_conv': nrm((N_C, DEC_BATCH, GDN_CONV - 1, 3 * GDN_DIM), 1.0),
        'state_ffn_conv': nrm((DEPTH, DEC_BATCH, FFN_CONV - 1, D_FF), 1.0),
        'meta_tokens': nrm((N_META, D_MODEL), 1.0),
        'w_in_ab': nrm((N_AB, D_MODEL, AB_COLS), D_MODEL ** -0.5),
        'gla_gate_w2': nrm((N_AB, GLA_GATE_RANK, GLA_DK), GLA_GATE_RANK ** -0.5),
        'gla_gate_b': nrm((N_AB, GLA_DK), 0.1),
        'gla_norm_g': ones_n((N_AB, GLA_DV)),
        'rwkv_mu': jax.random.uniform(next(ks), (N_AB, RWKV_COLS), f32, 0.0, 1.0),
        'rwkv_w0': w0,
        'rwkv_w2': nrm((N_AB, RWKV_DECAY_RANK, RWKV_DIM), 0.1 * RWKV_DECAY_RANK ** -0.5),
        'rwkv_a0': nrm((N_AB, RWKV_DIM), 0.1),
        'rwkv_a2': nrm((N_AB, RWKV_A_RANK, RWKV_DIM), RWKV_A_RANK ** -0.5),
        'rwkv_g2': nrm((N_AB, RWKV_GATE_RANK, RWKV_DIM), RWKV_GATE_RANK ** -0.5),
        'rwkv_k_k': 0.85 + nrm((N_AB, RWKV_DIM), 0.02),
        'rwkv_k_a': ones_n((N_AB, RWKV_DIM)),
        'rwkv_r_k': nrm((N_AB, RWKV_HEADS, RWKV_HEAD), 0.1),
        'rwkv_ln_g': ones_n((N_AB, RWKV_DIM)),
        'rwkv_ln_b': nrm((N_AB, RWKV_DIM), 0.02),
        'w_out_ab': nrm((N_AB, AB_OUT, D_MODEL), AB_OUT ** -0.5 * beta),
        'w_in_c': nrm((N_C, D_MODEL, C_COLS), D_MODEL ** -0.5),
        'gdn_conv_w': nrm((N_C, GDN_CONV, 3 * GDN_DIM), GDN_CONV ** -0.5),
        'gdn_A_log': a_log,
        'gdn_dt_bias': dt_bias,
        'gdn_norm_g': ones_n((N_C, GDN_HEAD)),
        'w_out_c': nrm((N_C, GDN_DIM, D_MODEL), GDN_DIM ** -0.5 * beta),
        'w_up': nrm((DEPTH, D_MODEL, 2 * D_FF), D_MODEL ** -0.5),
        'ffn_conv_w': nrm((DEPTH, FFN_CONV, D_FF), FFN_CONV ** -0.5),
        'ffn_conv_b': nrm((DEPTH, D_FF), 0.02),
        'w_down': nrm((DEPTH, D_FF, D_MODEL), D_FF ** -0.5 * beta),
        'ln_mix_g': ones_n((DEPTH, D_MODEL)),
        'ln_mix_b': nrm((DEPTH, D_MODEL), 0.02),
        'ln_ffn_g': ones_n((DEPTH, D_MODEL)),
        'ln_ffn_b': nrm((DEPTH, D_MODEL), 0.02),
    }


def reference(x_prompt, x_sample, state_gla, state_rwkv, state_rwkv_shift, state_gdn, state_gdn_conv,
              state_ffn_conv, meta_tokens, w_in_ab, gla_gate_w2, gla_gate_b, gla_norm_g, rwkv_mu, rwkv_w0,
              rwkv_w2, rwkv_a0, rwkv_a2, rwkv_g2, rwkv_k_k, rwkv_k_a, rwkv_r_k, rwkv_ln_g, rwkv_ln_b,
              w_out_ab, w_in_c, gdn_conv_w, gdn_A_log, gdn_dt_bias, gdn_norm_g, w_out_c, w_up,
              ffn_conv_w, ffn_conv_b, w_down, ln_mix_g, ln_mix_b, ln_ffn_g, ln_ffn_b):
    p = {
        'w_in_ab': w_in_ab, 'gla_gate_w2': gla_gate_w2, 'gla_gate_b': gla_gate_b, 'gla_norm_g': gla_norm_g,
        'rwkv_mu': rwkv_mu, 'rwkv_w0': rwkv_w0, 'rwkv_w2': rwkv_w2, 'rwkv_a0': rwkv_a0, 'rwkv_a2': rwkv_a2,
        'rwkv_g2': rwkv_g2, 'rwkv_k_k': rwkv_k_k, 'rwkv_k_a': rwkv_k_a, 'rwkv_r_k': rwkv_r_k,
        'rwkv_ln_g': rwkv_ln_g, 'rwkv_ln_b': rwkv_ln_b, 'w_out_ab': w_out_ab,
        'w_in_c': w_in_c, 'gdn_conv_w': gdn_conv_w, 'gdn_A_log': gdn_A_log, 'gdn_dt_bias': gdn_dt_bias,
        'gdn_norm_g': gdn_norm_g, 'w_out_c': w_out_c,
        'w_up': w_up, 'ffn_conv_w': ffn_conv_w, 'ffn_conv_b': ffn_conv_b, 'w_down': w_down,
        'ln_mix_g': ln_mix_g, 'ln_mix_b': ln_mix_b, 'ln_ffn_g': ln_ffn_g, 'ln_ffn_b': ln_ffn_b,
    }
    B = x_prompt.shape[0]
    dt = x_prompt.dtype
    meta = jnp.broadcast_to(meta_tokens.astype(dt)[None], (B, N_META, D_MODEL))
    xp = jnp.concatenate([meta, x_prompt], axis=1)
    zeros_like_state = lambda s: jnp.zeros((s.shape[0], B) + s.shape[2:], dt)
    (hp, p_gla, p_rwkv, p_shift, p_gdn, p_gdn_conv, p_ffn_conv) = _trunk(
        xp, zeros_like_state(state_gla), zeros_like_state(state_rwkv), zeros_like_state(state_rwkv_shift),
        zeros_like_state(state_gdn), zeros_like_state(state_gdn_conv), zeros_like_state(state_ffn_conv),
        p, N_META)
    y_prompt = hp[:, N_META:]
    (y_sample, s_gla, s_rwkv, s_shift, s_gdn, s_gdn_conv, s_ffn_conv) = _trunk(
        x_sample, state_gla, state_rwkv, state_rwkv_shift, state_gdn, state_gdn_conv, state_ffn_conv, p, 0)
    return (y_prompt, y_sample, p_gla, p_rwkv, p_shift, p_gdn, p_gdn_conv, p_ffn_conv,
            s_gla, s_rwkv, s_shift, s_gdn, s_gdn_conv, s_ffn_conv)
```

```cpp
#include <hip/hip_runtime.h>
#include <hip/hip_cooperative_groups.h>
#include <cstdio>
#include <cstdint>
namespace cg = cooperative_groups;

#ifndef MK_MULTI
#define MK_MULTI 1
#endif

namespace pg8 {
#define PG8_LAS __attribute__((address_space(3)))
typedef _Float16 bf16_t;
typedef _Float16 bf16x8 __attribute__((ext_vector_type(8)));
typedef float f32x4 __attribute__((ext_vector_type(4)));
typedef unsigned u32x4 __attribute__((ext_vector_type(4)));
constexpr int BM = 256, BK = 64, HALF = 128, HTB = HALF * BK * 2  , STAGE_BYTES = 8 * HTB, NXCD = 8, WGM = 8;

__host__ __device__ __forceinline__ int lds_byte(int r, int c) { const int st = (r >> 4) * 2 + (c >> 5), rr = r & 15, cc = c & 31, ob = rr * 64 + cc * 2; return st * 1024 + (ob ^ (((ob >> 9) & 1) << 5)); }
__host__ __device__ __forceinline__ void stage_rc(int b, int& R, int& C) { const int st = b / 1024, sb = b % 1024, swz = sb ^ (((sb >> 9) & 1) << 5); R = (st >> 1) * 16 + swz / 64; C = (st & 1) * 32 + (swz % 64) / 2; }
__host__ __device__ __forceinline__ int perm32(int rho) { const int n = rho >> 4, i = rho & 15; return 8 * (i >> 2) + 4 * n + (i & 3); }

struct Unit { int pm, pn; };
struct Gemm { const bf16_t* A; const bf16_t* Bt; int M, N, K; };

struct StaticOrder {
    int nM, nN, nwg, G, c;
    __host__ __device__ void init(int M, int N, int G_, int c_) { nM = M / BM; nN = N / BM; nwg = nM * nN; G = G_; c = c_; }
    __host__ __device__ bool next(int i, Unit& u) const {
        const long L = (long)i * G + c; if (L >= nwg) return false;
        int wgid = (int)L; { const int q = nwg / NXCD, r = nwg % NXCD, xcd = wgid % NXCD, off = wgid / NXCD; wgid = (xcd < r ? xcd * (q + 1) : r * (q + 1) + (xcd - r) * q) + off; }
        const int nig = WGM * nN, gid = wgid / nig, fm = gid * WGM, gsz = (nM - fm) < WGM ? (nM - fm) : WGM;
        u.pm = fm + ((wgid % nig) % gsz); u.pn = (wgid % nig) / gsz; return true;
    }
    __device__ __forceinline__ void a_ready(const Unit&) const {}
    __device__ __forceinline__ void done(const Unit&) const {}
};


struct EpiZ {
    static constexpr bool PERM = true, AFTER_DRAIN = false;
    bf16_t* O; int ldc;
    __device__ __forceinline__ void operator()(const f32x4 (&acc)[2][2][4][2], const Unit& u, int wr, int wc, int fr, int fq) const {
        const int row0 = u.pm * BM + wr * 64 + fr, col0 = u.pn * BM + wc * 32 + 8 * fq;
#pragma unroll
        for (int ai = 0; ai < 2; ++ai)
#pragma unroll
            for (int m = 0; m < 4; ++m) { bf16_t* rowp = O + (size_t)(row0 + ai * HALF + m * 16) * ldc + col0;
#pragma unroll
                for (int bj = 0; bj < 2; ++bj) { const f32x4 v0 = acc[ai][bj][m][0], v1 = acc[ai][bj][m][1];
                    bf16x8 w; w[0] = (bf16_t)v0[0]; w[1] = (bf16_t)v0[1]; w[2] = (bf16_t)v0[2]; w[3] = (bf16_t)v0[3]; w[4] = (bf16_t)v1[0]; w[5] = (bf16_t)v1[1]; w[6] = (bf16_t)v1[2]; w[7] = (bf16_t)v1[3];
                    *(bf16x8*)(rowp + bj * HALF) = w; } }
    }
};
struct EpiRes {
    static constexpr bool PERM = false, AFTER_DRAIN = false;
    float* X; float alpha;
    __device__ __forceinline__ void operator()(const f32x4 (&acc)[2][2][4][2], const Unit& u, int wr, int wc, int fr, int fq) const {
        const int row0 = u.pm * BM + wr * 64 + fr, col0 = u.pn * BM + wc * 32 + 4 * fq;
#pragma unroll
        for (int ai = 0; ai < 2; ++ai)
#pragma unroll
            for (int m = 0; m < 4; ++m) { float* rowp = X + (size_t)(row0 + ai * HALF + m * 16) * 1024 + col0;
#pragma unroll
                for (int bj = 0; bj < 2; ++bj)
#pragma unroll
                    for (int n = 0; n < 2; ++n) { f32x4* p = (f32x4*)(rowp + bj * HALF + n * 16); const f32x4 x = *p; *p = x * alpha + acc[ai][bj][m][n]; } }
    }
};

template <class Epi, class Sched, bool ALIGN_EPI = false, bool SP2 = false>
__device__ __forceinline__ void gemm_phase(PG8_LAS unsigned char* lds, const Gemm g, const Sched& S, const Epi& E, const int tid) {
    const int wid = __builtin_amdgcn_readfirstlane(tid >> 6), lane = tid & 63, wr = wid >> 2, wc = wid & 3, fr = lane & 15, fq = lane >> 4;
    const int K = g.K, nt = K / BK;
    unsigned voffA[2], voffB[2];
#pragma unroll
    for (int i = 0; i < 2; ++i) { int R, C; stage_rc(tid * 16 + i * 8192, R, C); const int Rb = Epi::PERM ? ((R & ~31) + perm32(R & 31)) : R;
        voffA[i] = (unsigned)(R * K + C) * 2u; voffB[i] = (unsigned)(Rb * K + C) * 2u; }
    const size_t kstep = (size_t)(BK * 2);
    const size_t hstep = (size_t)HALF * K * 2;
    const size_t tstep = 2 * hstep;
    const unsigned ldsw = (unsigned)wid * 1024u;
    const int aoff = lds_byte(wr * 64 + fr, fq * 8), boff = lds_byte(wc * 32 + fr, fq * 8);
#define PG8_SA(b, h) (((b) * 2 + (h)) * HTB)
#define PG8_SB(b, h) ((4 + (b) * 2 + (h)) * HTB)
#define PG8_STAGE(bufoff, gbase, voff) do { _Pragma("unroll") for (int _i = 0; _i < 2; ++_i) \
        __builtin_amdgcn_global_load_lds((const unsigned*)((const char*)(gbase) + (voff)[_i]), (PG8_LAS unsigned*)(lds + (bufoff) + ldsw + _i * 8192), 16, 0, 0); } while (0)
#define PG8_LDA(dst, b, h) do { _Pragma("unroll") for (int m = 0; m < 4; ++m) _Pragma("unroll") for (int k = 0; k < 2; ++k) dst[m][k] = *(const PG8_LAS bf16x8*)(lds + PG8_SA(b, h) + aoff + m * 2048 + k * 1024); } while (0)
#define PG8_LDB(dst, b, h) do { _Pragma("unroll") for (int n = 0; n < 2; ++n) _Pragma("unroll") for (int k = 0; k < 2; ++k) dst[n][k] = *(const PG8_LAS bf16x8*)(lds + PG8_SB(b, h) + boff + n * 2048 + k * 1024); } while (0)
#define PG8_MMA(ai, bj, At, Bt) do { __builtin_amdgcn_s_setprio(1); _Pragma("unroll") for (int m = 0; m < 4; ++m) _Pragma("unroll") for (int n = 0; n < 2; ++n) _Pragma("unroll") for (int k = 0; k < 2; ++k) \
        acc[ai][bj][m][n] = __builtin_amdgcn_mfma_f32_16x16x32_f16(Bt[n][k], At[m][k], acc[ai][bj][m][n], 0, 0, 0); __builtin_amdgcn_s_setprio(0); } while (0)
#define PG8_WAIT_V(n) asm volatile("s_waitcnt vmcnt(" #n ")" ::: "memory")
#define PG8_WAIT_L(n) asm volatile("s_waitcnt lgkmcnt(" #n ")" ::: "memory")
#define PG8_BAR __builtin_amdgcn_s_barrier()
#define PG8_SCHED __builtin_amdgcn_sched_barrier(0)
    Unit cur, nxt; int ui = 0;
    if (!S.next(0, cur)) return;
    f32x4 acc[2][2][4][2];
#pragma unroll
    for (int a = 0; a < 2; ++a)
#pragma unroll
        for (int b = 0; b < 2; ++b)
#pragma unroll
            for (int m = 0; m < 4; ++m)
#pragma unroll
                for (int n = 0; n < 2; ++n) acc[a][b][m][n] = (f32x4){0.f, 0.f, 0.f, 0.f};
    bf16x8 At[4][2], B0[2][2], B1[2][2];
    const char* cA = (const char*)g.A + (size_t)cur.pm * tstep; const char* cB = (const char*)g.Bt + (size_t)cur.pn * tstep;
    S.a_ready(cur);
    if constexpr (SP2) {
        PG8_STAGE(PG8_SB(0, 0), cB, voffB); PG8_STAGE(PG8_SB(0, 1), cB + hstep, voffB); PG8_STAGE(PG8_SA(0, 0), cA, voffA); PG8_STAGE(PG8_SA(0, 1), cA + hstep, voffA);
        if (wr == 1) PG8_BAR;
        PG8_WAIT_V(2); PG8_BAR;
        PG8_STAGE(PG8_SB(1, 0), cB + kstep, voffB); PG8_STAGE(PG8_SA(1, 0), cA + kstep, voffA); PG8_STAGE(PG8_SB(1, 1), cB + hstep + kstep, voffB);
        PG8_WAIT_V(6); PG8_BAR;
    } else {
        PG8_STAGE(PG8_SB(0, 0), cB, voffB); PG8_STAGE(PG8_SA(0, 0), cA, voffA); PG8_STAGE(PG8_SB(0, 1), cB + hstep, voffB); PG8_STAGE(PG8_SA(0, 1), cA + hstep, voffA);
        if (wr == 1) PG8_BAR;
        PG8_WAIT_V(4); PG8_BAR;
        PG8_STAGE(PG8_SB(1, 0), cB + kstep, voffB); PG8_STAGE(PG8_SA(1, 0), cA + kstep, voffA); PG8_STAGE(PG8_SB(1, 1), cB + hstep + kstep, voffB);
        PG8_WAIT_V(6); PG8_BAR;
    }
    for (;;) {
        const bool has_next = S.next(ui + 1, nxt);
        const char* nA = has_next ? (const char*)g.A + (size_t)nxt.pm * tstep : cA; const char* nB = has_next ? (const char*)g.Bt + (size_t)nxt.pn * tstep : cB;
        for (int t = 0; t < nt; t += 2) {
            const bool last = (t == nt - 2);
            const char* a1 = cA + (size_t)(t + 1) * kstep;
            const char* a2 = last ? nA : cA + (size_t)(t + 2) * kstep; const char* b2 = last ? nB : cB + (size_t)(t + 2) * kstep;
            const char* a3 = a2 + kstep; const char* b3 = b2 + kstep;
            if (last && has_next) S.a_ready(nxt);
            if constexpr (SP2) {
            PG8_LDB(B0, 0, 0); PG8_LDB(B1, 0, 1); PG8_SCHED; PG8_LDA(At, 0, 0); PG8_STAGE(PG8_SA(1, 1), a1 + hstep, voffA);
            PG8_WAIT_V(8); PG8_WAIT_L(0); PG8_BAR; PG8_MMA(0, 0, At, B0); PG8_MMA(0, 1, At, B1); PG8_BAR; PG8_SCHED;
            PG8_LDA(At, 0, 1); PG8_STAGE(PG8_SB(0, 0), b2, voffB); PG8_STAGE(PG8_SB(0, 1), b2 + hstep, voffB); PG8_STAGE(PG8_SA(0, 0), a2, voffA);
            PG8_WAIT_V(8); PG8_WAIT_L(0); PG8_BAR; PG8_MMA(1, 0, At, B0); PG8_MMA(1, 1, At, B1); PG8_BAR; PG8_SCHED;
            PG8_LDB(B0, 1, 0); PG8_LDB(B1, 1, 1); PG8_SCHED; PG8_LDA(At, 1, 0); PG8_STAGE(PG8_SA(0, 1), a2 + hstep, voffA);
            PG8_WAIT_V(8); PG8_WAIT_L(0); PG8_BAR; PG8_MMA(0, 0, At, B0); PG8_MMA(0, 1, At, B1); PG8_BAR; PG8_SCHED;
            PG8_LDA(At, 1, 1); PG8_STAGE(PG8_SB(1, 0), b3, voffB); PG8_STAGE(PG8_SB(1, 1), b3 + hstep, voffB); PG8_STAGE(PG8_SA(1, 0), a3, voffA);
            PG8_WAIT_V(8); PG8_WAIT_L(0); PG8_BAR; PG8_MMA(1, 0, At, B0); PG8_MMA(1, 1, At, B1); PG8_BAR; PG8_SCHED;
            } else {
            PG8_LDB(B0, 0, 0); PG8_SCHED; PG8_LDA(At, 0, 0); PG8_STAGE(PG8_SA(1, 1), a1 + hstep, voffA);
            PG8_WAIT_L(8); PG8_BAR; PG8_WAIT_L(0); PG8_MMA(0, 0, At, B0); PG8_BAR; PG8_SCHED;
            PG8_LDB(B1, 0, 1); PG8_STAGE(PG8_SB(0, 0), b2, voffB);
            PG8_BAR; PG8_WAIT_L(0); PG8_MMA(0, 1, At, B1); PG8_BAR;
            PG8_LDA(At, 0, 1); PG8_STAGE(PG8_SA(0, 0), a2, voffA);
            PG8_BAR; PG8_WAIT_L(0); PG8_MMA(1, 0, At, B0); PG8_BAR; PG8_SCHED;
            PG8_STAGE(PG8_SB(0, 1), b2 + hstep, voffB);
            PG8_WAIT_V(6); PG8_BAR; PG8_MMA(1, 1, At, B1); PG8_BAR;
            PG8_LDB(B0, 1, 0); PG8_SCHED; PG8_LDA(At, 1, 0); PG8_STAGE(PG8_SA(0, 1), a2 + hstep, voffA);
            PG8_WAIT_L(8); PG8_BAR; PG8_WAIT_L(0); PG8_MMA(0, 0, At, B0); PG8_BAR; PG8_SCHED;
            PG8_LDB(B1, 1, 1); PG8_STAGE(PG8_SB(1, 0), b3, voffB);
            PG8_BAR; PG8_WAIT_L(0); PG8_MMA(0, 1, At, B1); PG8_BAR;
            PG8_LDA(At, 1, 1); PG8_STAGE(PG8_SA(1, 0), a3, voffA);
            PG8_BAR; PG8_WAIT_L(0); PG8_MMA(1, 0, At, B0); PG8_BAR; PG8_SCHED;
            PG8_STAGE(PG8_SB(1, 1), b3 + hstep, voffB);
            PG8_WAIT_V(6); PG8_BAR; PG8_MMA(1, 1, At, B1); PG8_BAR;
            }
        }
        if constexpr (ALIGN_EPI) { if (wr == 0) PG8_BAR; }
        if constexpr (!Epi::AFTER_DRAIN) { E(acc, cur, wr, wc, fr, fq); S.done(cur); }
        if (!has_next) break;
#pragma unroll
        for (int a = 0; a < 2; ++a)
#pragma unroll
            for (int b = 0; b < 2; ++b)
#pragma unroll
                for (int m = 0; m < 4; ++m)
#pragma unroll
                    for (int n = 0; n < 2; ++n) acc[a][b][m][n] = (f32x4){0.f, 0.f, 0.f, 0.f};
        cur = nxt; cA = nA; cB = nB; ++ui;
        if constexpr (ALIGN_EPI) { if (wr == 1) PG8_BAR; }
    }
    PG8_WAIT_V(0);
    if constexpr (!ALIGN_EPI) { if (wr == 0) PG8_BAR; }
    PG8_BAR;
    if constexpr (Epi::AFTER_DRAIN) { E.fused(acc, cur, wr, wc, fr, fq, lds, wid, lane); S.done(cur); }
#undef PG8_SA
#undef PG8_SB
#undef PG8_STAGE
#undef PG8_LDA
#undef PG8_LDB
#undef PG8_MMA
#undef PG8_WAIT_V
#undef PG8_WAIT_L
#undef PG8_BAR
#undef PG8_SCHED
}
}

#define LAS __attribute__((address_space(3)))
#define DEVINL __device__ __forceinline__
typedef _Float16 half_t;
typedef _Float16 h8 __attribute__((ext_vector_type(8)));
typedef _Float16 h4 __attribute__((ext_vector_type(4)));
typedef _Float16 h2 __attribute__((ext_vector_type(2)));
typedef float f32x4 __attribute__((ext_vector_type(4)));
typedef float f32x2 __attribute__((ext_vector_type(2)));

constexpr int NWAVES = 8, NTHREADS = 512;
constexpr int D = 1024, TP = 2064, NBP = 8, NTP = NBP * TP, NBS = 128, TSS = 4, NTS = NBS * TSS, NT = NTP + NTS, MP = 17152;
static_assert(NTP == 16512 && NT == 17024 && MP % 256 == 0 && MP >= NT + NBS, "rows");
constexpr int LDZ_AB = 3584, LDZ_C = 4352, DFF = 2816, LDH = 2 * DFF;
constexpr int ZR = 1792;
constexpr float ALPHA = 1.6817928305074292f;
constexpr int NSEQ = NBP + NBS;

constexpr size_t O_YP = 0, O_YS = O_YP + (size_t)NBP * 2048 * D, O_PGLA = O_YS + (size_t)NTS * D, O_PRWKV = O_PGLA + (size_t)2 * 8 * 4 * 64 * 128,
    O_PSHIFT = O_PRWKV + (size_t)2 * 8 * 8 * 64 * 64, O_PGDN = O_PSHIFT + (size_t)2 * 8 * D, O_PGDNCONV = O_PGDN + (size_t)2 * 8 * 8 * 128 * 128,
    O_PFFNCONV = O_PGDNCONV + (size_t)2 * 8 * 3 * 3072, O_SGLA = O_PFFNCONV + (size_t)4 * 8 * 2 * DFF, O_SRWKV = O_SGLA + (size_t)2 * 128 * 4 * 64 * 128,
    O_SSHIFT = O_SRWKV + (size_t)2 * 128 * 8 * 64 * 64, O_SGDN = O_SSHIFT + (size_t)2 * 128 * D, O_SGDNCONV = O_SGDN + (size_t)2 * 128 * 8 * 128 * 128,
    O_SFFNCONV = O_SGDNCONV + (size_t)2 * 128 * 3 * 3072, O_END = O_SFFNCONV + (size_t)4 * 128 * 2 * DFF;
static_assert(O_END == 76627968, "output size");

constexpr size_t MiB = 1u << 20;
constexpr size_t WS_WIN = 1 * MiB, WS_WOUT = 10 * MiB, WS_WUP = 12 * MiB, WS_WDN = 23 * MiB;
constexpr size_t WS_X = 32 * MiB, WS_XB = 100 * MiB, WS_MO = 134 * MiB  , WS_FREE = 168 * MiB, WS_BIG = 227 * MiB;
constexpr size_t WS_GA = WS_FREE, WS_OG = WS_FREE + 17 * MiB, WS_YR = WS_FREE + 34 * MiB;
constexpr size_t WS_OD = WS_FREE;
constexpr size_t WS_Z = WS_BIG;
constexpr size_t WS_RPH = WS_BIG + 119 * MiB, WS_RPW = WS_BIG + 219 * MiB, WS_BON = WS_BIG + 253 * MiB;
constexpr size_t WS_GQ = WS_BIG + 143 * MiB, WS_GK = WS_GQ + 34 * MiB, WS_GV = WS_GK + 34 * MiB, WS_GS = WS_GV + 34 * MiB;
constexpr size_t WS_END = WS_BIG + 255 * MiB;
static_assert(WS_X + (size_t)MP * D * 4 <= WS_XB && WS_XB + (size_t)MP * D * 2 <= WS_MO && WS_MO + (size_t)MP * DFF * 2 <= WS_BIG && WS_MO + (size_t)MP * D * 2 <= WS_FREE, "ws map 1");
static_assert(WS_YR + (size_t)NT * 512 * 2 <= WS_BIG && WS_OD + (size_t)NT * 1024 * 2 <= WS_BIG && WS_GA + (size_t)NT * 256 * 4 <= WS_OG && WS_OG + (size_t)NT * 512 * 2 <= WS_YR, "ws map 2");
static_assert(WS_Z + (size_t)MP * LDZ_AB * 2 <= WS_RPH && WS_RPH + (size_t)NT * 6 * 512 * 2 <= WS_RPW && WS_RPW + (size_t)NT * 512 * 4 <= WS_BON && WS_BON + (size_t)NT * 8 * 4 <= WS_END, "ws map 3");
static_assert(WS_Z + (size_t)MP * LDZ_C * 2 <= WS_GQ && WS_GS + (size_t)NT * 32 * 4 <= WS_END && WS_Z + (size_t)MP * LDH * 2 <= WS_END, "ws map 4");
static_assert(WS_WIN + (size_t)LDZ_C * D * 2 <= WS_WOUT && WS_WOUT + (size_t)D * D * 2 <= WS_WUP && WS_WUP + (size_t)LDH * D * 2 <= WS_WDN && WS_WDN + (size_t)D * DFF * 2 <= WS_X, "ws map 5");

constexpr int LDS_BYTES = 147456;

struct Params { const float* in[39]; float* out; unsigned char* ws; int ph_lo, ph_hi; };

DEVINL float wave_sum(float v) {
#pragma unroll
    for (int o = 1; o < 64; o <<= 1) v += __shfl_xor(v, o);
    return v;
}
DEVINL float red16(float v) { v += __shfl_xor(v, 1); v += __shfl_xor(v, 2); v += __shfl_xor(v, 4); v += __shfl_xor(v, 8); return v; }
DEVINL float sigmoidf_(float x) { return 1.f / (1.f + __expf(-x)); }
DEVINL float siluf_(float x) { return x / (1.f + __expf(-x)); }
DEVINL f32x4 ld_h4(const half_t* p) { const h4 v = *(const h4*)p; return (f32x4){(float)v[0], (float)v[1], (float)v[2], (float)v[3]}; }
DEVINL void st_h4(half_t* p, f32x4 v) { h4 o; o[0] = (half_t)v[0]; o[1] = (half_t)v[1]; o[2] = (half_t)v[2]; o[3] = (half_t)v[3]; *(h4*)p = o; }
#define LDS_WAIT() asm volatile("s_waitcnt lgkmcnt(0)" ::: "memory")

DEVINL void row_info(int row, int& t, int& sb) { if (row < NTP) { t = row % TP; sb = -1; } else { const int r = row - NTP; t = r & 3; sb = r >> 2; } }

template <int MODE> DEVINL int src_col(int dst, int N) {
    if (MODE == 0) return dst < N ? dst : -1;
    if (dst < 1024) return dst;
    if (dst < 1536) return 1040 + (dst - 1024);
    if (dst < 1552) return 1024 + (dst - 1536);
    if (dst < ZR) return -1;
    return 1552 + (dst - ZR);
}
template <int MODE> DEVINL void convert_w(const float* __restrict__ W, int K, int N, int Npad, half_t* __restrict__ WT, LAS float* scr, int gw, int ngw, int lane) {
    const int nblk = Npad / 32, nitems = (K / 64) * nblk;
    for (int it = gw; it < nitems; it += ngw) {
        const int kb = it / nblk, nb = it - kb * nblk, k0 = 64 * kb, n0 = 32 * nb;
        const int sc = src_col<MODE>(n0 + (lane & 31), N);
#pragma unroll 8
        for (int i = 0; i < 32; ++i) { const int kk = 2 * i + (lane >> 5); scr[kk * 33 + (lane & 31)] = sc >= 0 ? W[(size_t)(k0 + kk) * N + sc] : 0.f; }
        LDS_WAIT();
        const int c = lane & 7;
#pragma unroll
        for (int j = 0; j < 4; ++j) { const int n = (lane >> 3) + 8 * j; const LAS float* s = scr + (8 * c) * 33 + n;
            h8 o;
#pragma unroll
            for (int e = 0; e < 8; ++e) o[e] = (half_t)s[e * 33];
            *(h8*)(WT + (size_t)(n0 + n) * K + k0 + 8 * c) = o; }
        LDS_WAIT();
    }
}
DEVINL void convert_layer_weights(const Params& P, int l, LAS unsigned char* lds, int gw, int ngw, int lane, int wave) {
    LAS float* scr = (LAS float*)(lds + wave * 16384);
    const int i = l >> 1;
    if ((l & 1) == 0) {
        convert_w<1>(P.in[9] + (size_t)i * D * 3344, D, 3344, LDZ_AB, (half_t*)(P.ws + WS_WIN), scr, gw, ngw, lane);
        convert_w<0>(P.in[24] + (size_t)i * D * D, D, D, D, (half_t*)(P.ws + WS_WOUT), scr, gw, ngw, lane);
    } else {
        convert_w<0>(P.in[25] + (size_t)i * D * 4112, D, 4112, LDZ_C, (half_t*)(P.ws + WS_WIN), scr, gw, ngw, lane);
        convert_w<0>(P.in[30] + (size_t)i * D * D, D, D, D, (half_t*)(P.ws + WS_WOUT), scr, gw, ngw, lane);
    }
    convert_w<0>(P.in[31] + (size_t)l * D * LDH, D, LDH, LDH, (half_t*)(P.ws + WS_WUP), scr, gw, ngw, lane);
    convert_w<0>(P.in[34] + (size_t)l * DFF * D, DFF, D, D, (half_t*)(P.ws + WS_WDN), scr, gw, ngw, lane);
}

DEVINL void phase_prologue(const Params& P, int gw, int ngw, int lane) {
    float* X = (float*)(P.ws + WS_X); half_t* XB = (half_t*)(P.ws + WS_XB);
    for (int row = gw; row < MP; row += ngw) {
        const float* src; float* sh = nullptr;
        if (row < NTP) { const int b = row / TP, t = row - b * TP; src = t < 16 ? P.in[8] + (size_t)t * D : P.in[0] + ((size_t)b * 2048 + (t - 16)) * D; if (t == TP - 1) sh = P.out + O_PSHIFT + (size_t)b * D; }
        else if (row < NT) { const int r = row - NTP; src = P.in[1] + (size_t)r * D; if ((r & 3) == 3) sh = P.out + O_SSHIFT + (size_t)(r >> 2) * D; }
        else if (row < NT + NBS) src = P.in[4] + (size_t)(row - NT) * D;
        else src = nullptr;
#pragma unroll
        for (int j = 0; j < 4; ++j) {
            const f32x4 v = src ? ((const f32x4*)src)[lane + 64 * j] : (f32x4){0.f, 0.f, 0.f, 0.f};
            if (row < NT) ((f32x4*)(X + (size_t)row * D))[lane + 64 * j] = v;
            st_h4(XB + (size_t)row * D + 4 * (lane + 64 * j), v);
            if (sh) ((f32x4*)sh)[lane + 64 * j] = v;
        }
    }
}

DEVINL void phase_ln(const Params& P, const float* __restrict__ g, const float* __restrict__ bta, bool final, int shift_i, int gw, int ngw, int lane) {
    float* X = (float*)(P.ws + WS_X); half_t* XB = (half_t*)(P.ws + WS_XB);
    f32x4 gv[4], bv[4];
#pragma unroll
    for (int j = 0; j < 4; ++j) { gv[j] = ((const f32x4*)g)[lane + 64 * j]; bv[j] = ((const f32x4*)bta)[lane + 64 * j]; }
    for (int row = gw; row < NT; row += ngw) {
        f32x4* xr = (f32x4*)(X + (size_t)row * D);
        f32x4 v[4]; float s = 0.f;
#pragma unroll
        for (int j = 0; j < 4; ++j) { v[j] = xr[lane + 64 * j]; s += (v[j][0] + v[j][1]) + (v[j][2] + v[j][3]); }
        const float mean = wave_sum(s) * (1.f / D); float s2 = 0.f;
#pragma unroll
        for (int j = 0; j < 4; ++j) { v[j] = v[j] - mean; s2 += (v[j][0] * v[j][0] + v[j][1] * v[j][1]) + (v[j][2] * v[j][2] + v[j][3] * v[j][3]); }
        const float rstd = rsqrtf(wave_sum(s2) * (1.f / D) + 1e-5f);
        int t, sb; row_info(row, t, sb);
        float* dst = nullptr; float* sh = nullptr;
        if (final) { if (sb >= 0) dst = P.out + O_YS + (size_t)(row - NTP) * D; else if (t >= 16) dst = P.out + O_YP + ((size_t)(row / TP) * 2048 + (t - 16)) * D; }
        if (shift_i >= 0) { if (sb >= 0) { if (t == 3) sh = P.out + O_SSHIFT + ((size_t)shift_i * NBS + sb) * D; } else if (t == TP - 1) sh = P.out + O_PSHIFT + ((size_t)shift_i * NBP + row / TP) * D; }
#pragma unroll
        for (int j = 0; j < 4; ++j) {
            const f32x4 y = v[j] * rstd * gv[j] + bv[j];
            if (final) { if (dst) ((f32x4*)dst)[lane + 64 * j] = y; }
            else { xr[lane + 64 * j] = y; st_h4(XB + (size_t)row * D + 4 * (lane + 64 * j), y); }
            if (sh) ((f32x4*)sh)[lane + 64 * j] = y;
        }
    }
    if (shift_i >= 0) {
        const float* st = P.in[4] + (size_t)shift_i * NBS * D;
        for (int b = gw; b < NBS; b += ngw)
#pragma unroll
            for (int j = 0; j < 4; ++j) st_h4(XB + (size_t)(NT + b) * D + 4 * (lane + 64 * j), ((const f32x4*)(st + (size_t)b * D))[lane + 64 * j]);
    }
}

DEVINL void phase_act(const Params& P, int l, int gw, int ngw, int lane) {
    const half_t* H = (const half_t*)(P.ws + WS_Z); half_t* A2 = (half_t*)(P.ws + WS_MO);
    const float* cw = P.in[32] + (size_t)l * 3 * DFF; const float* cb = P.in[33] + (size_t)l * DFF; const float* st = P.in[7] + (size_t)l * NBS * 2 * DFF;
    for (int row = gw; row < NT; row += ngw) {
        int t, sb; row_info(row, t, sb);
        const half_t* h0 = H + (size_t)row * LDH;
#pragma unroll 2
        for (int p = 0; p < 11; ++p) {
            const int c = p * 256 + lane * 4;
            const f32x4 g0 = ld_h4(h0 + c), up = ld_h4(h0 + DFF + c);
            f32x4 g1 = {0.f, 0.f, 0.f, 0.f}, g2 = {0.f, 0.f, 0.f, 0.f};
            if (t >= 1) g1 = ld_h4(h0 - LDH + c); else if (sb >= 0) g1 = *(const f32x4*)(st + ((size_t)sb * 2 + 1) * DFF + c);
            if (t >= 2) g2 = ld_h4(h0 - 2 * LDH + c); else if (sb >= 0) g2 = *(const f32x4*)(st + ((size_t)sb * 2 + t) * DFF + c);
            const f32x4 w0 = *(const f32x4*)(cw + c), w1 = *(const f32x4*)(cw + DFF + c), w2 = *(const f32x4*)(cw + 2 * DFF + c), bb = *(const f32x4*)(cb + c);
            const f32x4 x = w2 * g0 + w1 * g1 + w0 * g2 + bb;
            f32x4 o;
#pragma unroll
            for (int e = 0; e < 4; ++e) o[e] = siluf_(x[e]) * up[e];
            st_h4(A2 + (size_t)row * DFF + c, o);
        }
    }
    for (int q = gw; q < NSEQ * 2; q += ngw) {
        const int s = q >> 1, j = q & 1;
        const int row = s < NBP ? s * TP + TP - 2 + j : NTP + (s - NBP) * 4 + 2 + j;
        float* dst = s < NBP ? P.out + O_PFFNCONV + (((size_t)l * NBP + s) * 2 + j) * DFF : P.out + O_SFFNCONV + (((size_t)l * NBS + (s - NBP)) * 2 + j) * DFF;
        for (int p = 0; p < 11; ++p) { const int c = p * 256 + lane * 4; *(f32x4*)(dst + c) = ld_h4(H + (size_t)row * LDH + c); }
    }
}

DEVINL const half_t* zprev_row(const half_t* Z, int row, int ldz) {
    if (row < NTP) return (row % TP) == 0 ? nullptr : Z + (size_t)(row - 1) * ldz;
    const int r = row - NTP; return (r & 3) == 0 ? Z + (size_t)(NT + (r >> 2)) * ldz : Z + (size_t)(row - 1) * ldz;
}
DEVINL void phase_prep_ab(const Params& P, int i, LAS unsigned char* lds, int tid, int lane, int wave, int G) {
    const half_t* Z = (const half_t*)(P.ws + WS_Z);
    half_t* RPH = (half_t*)(P.ws + WS_RPH); float* RPW = (float*)(P.ws + WS_RPW); float* BON = (float*)(P.ws + WS_BON); float* GA = (float*)(P.ws + WS_GA);
    const float* mu = P.in[13] + (size_t)i * 1792; const float* w0 = P.in[14] + i * 512; const float* w2 = P.in[15] + (size_t)i * 64 * 512;
    const float* a0 = P.in[16] + i * 512; const float* a2 = P.in[17] + (size_t)i * 64 * 512; const float* g2 = P.in[18] + (size_t)i * 128 * 512;
    const float* k_k = P.in[19] + i * 512; const float* k_a = P.in[20] + i * 512; const float* r_k = P.in[21] + i * 512;
    const float* gw2 = P.in[10] + (size_t)i * 16 * 256; const float* gb = P.in[11] + i * 256;
    LAS float* LA = (LAS float*)lds;
    LAS float* LG = LA + 8 * 256;
    const int j = tid;
    const float mu_r = mu[j], mu_k = mu[512 + j], mu_v = mu[1024 + j], kkj = k_k[j], kaj = k_a[j], rkj = r_k[j], w0j = w0[j], a0j = a0[j];
    for (int tile = blockIdx.x; tile < NT / 8; tile += G) {
        const int r0 = tile * 8;
        {
            const int tt = tid >> 6, c4 = (tid & 63) * 4, row = r0 + tt;
            const half_t* zc = Z + (size_t)row * LDZ_AB + ZR + 1536 + c4; const half_t* zp = zprev_row(Z, row, LDZ_AB);
            const f32x4 cur = ld_h4(zc); const f32x4 prv = zp ? ld_h4(zp + ZR + 1536 + c4) : (f32x4){0.f, 0.f, 0.f, 0.f};
            const f32x4 m = *(const f32x4*)(mu + 1536 + c4);
            const f32x4 zz = cur + m * (prv - cur);
#pragma unroll
            for (int e = 0; e < 4; ++e) { float v = zz[e]; if (c4 < 64) v = tanhf(v); else if (c4 >= 128) v = sigmoidf_(v); LA[(c4 + e) * 8 + tt] = v; }
            if (tid < 128) { const int t2 = tid >> 4, c = tid & 15; LG[t2 * 16 + c] = (float)Z[(size_t)(r0 + t2) * LDZ_AB + 1536 + c]; }
        }
        __syncthreads();
        LAS float* LALR = LG + 8 * 16;
        {   float acc[8];
#pragma unroll
            for (int tt = 0; tt < 8; ++tt) acc[tt] = w0j;
#pragma unroll 4
            for (int k = 0; k < 64; ++k) { const float w = w2[(size_t)k * 512 + j]; const f32x4 x0 = *(const LAS f32x4*)(LA + k * 8), x1 = *(const LAS f32x4*)(LA + k * 8 + 4);
                acc[0] += x0[0] * w; acc[1] += x0[1] * w; acc[2] += x0[2] * w; acc[3] += x0[3] * w; acc[4] += x1[0] * w; acc[5] += x1[1] * w; acc[6] += x1[2] * w; acc[7] += x1[3] * w; }
#pragma unroll
            for (int tt = 0; tt < 8; ++tt) RPW[(size_t)(r0 + tt) * 512 + j] = __expf(-0.6065306597126334f * sigmoidf_(acc[tt]));
        }
        {   float acc[8];
#pragma unroll
            for (int tt = 0; tt < 8; ++tt) acc[tt] = a0j;
#pragma unroll 4
            for (int k = 0; k < 64; ++k) { const float w = a2[(size_t)k * 512 + j]; const f32x4 x0 = *(const LAS f32x4*)(LA + (64 + k) * 8), x1 = *(const LAS f32x4*)(LA + (64 + k) * 8 + 4);
                acc[0] += x0[0] * w; acc[1] += x0[1] * w; acc[2] += x0[2] * w; acc[3] += x0[3] * w; acc[4] += x1[0] * w; acc[5] += x1[1] * w; acc[6] += x1[2] * w; acc[7] += x1[3] * w; }
#pragma unroll
            for (int tt = 0; tt < 8; ++tt) LALR[tt * 512 + j] = sigmoidf_(acc[tt]);
        }
        {   float acc[8];
#pragma unroll
            for (int tt = 0; tt < 8; ++tt) acc[tt] = 0.f;
#pragma unroll 4
            for (int k = 0; k < 128; ++k) { const float w = g2[(size_t)k * 512 + j]; const f32x4 x0 = *(const LAS f32x4*)(LA + (128 + k) * 8), x1 = *(const LAS f32x4*)(LA + (128 + k) * 8 + 4);
                acc[0] += x0[0] * w; acc[1] += x0[1] * w; acc[2] += x0[2] * w; acc[3] += x0[3] * w; acc[4] += x1[0] * w; acc[5] += x1[1] * w; acc[6] += x1[2] * w; acc[7] += x1[3] * w; }
#pragma unroll
            for (int tt = 0; tt < 8; ++tt) RPH[(size_t)(r0 + tt) * 3072 + 2560 + j] = (half_t)acc[tt];
        }
#pragma unroll 1
        for (int tt = 0; tt < 8; ++tt) {
            const int row = r0 + tt;
            const half_t* zc = Z + (size_t)row * LDZ_AB + ZR; const half_t* zp = zprev_row(Z, row, LDZ_AB);
            float cr = (float)zc[j], ck = (float)zc[512 + j], cv = (float)zc[1024 + j], pr = 0.f, pk = 0.f, pv = 0.f;
            if (zp) { pr = (float)zp[ZR + j]; pk = (float)zp[ZR + 512 + j]; pv = (float)zp[ZR + 1024 + j]; }
            const float r = cr + mu_r * (pr - cr), kr = ck + mu_k * (pk - ck), vr = cv + mu_v * (pv - cv);
            const float alr = LALR[tt * 512 + j];
            const float kkraw = kr * kkj; const float ss = wave_sum(kkraw * kkraw); const float kk = kkraw * rsqrtf(ss + 1e-6f);
            const float kmod = kr * (1.f + (alr - 1.f) * kaj);
            const float bon = wave_sum(r * kmod * rkj);
            half_t* rp = RPH + (size_t)row * 6 * 512 + j;
            rp[0] = (half_t)r; rp[512] = (half_t)kmod; rp[1024] = (half_t)vr; rp[1536] = (half_t)kk; rp[2048] = (half_t)(kk * alr);
            if (lane == 0) BON[(size_t)row * 8 + wave] = bon;
        }
        if (tid < 256) {
            float wr[16];
#pragma unroll
            for (int k = 0; k < 16; ++k) wr[k] = gw2[k * 256 + tid];
            const float gbj = gb[tid];
#pragma unroll
            for (int tt = 0; tt < 8; ++tt) { float acc = gbj;
#pragma unroll
                for (int k = 0; k < 16; ++k) acc += LG[tt * 16 + k] * wr[k];
                const float ls = fminf(acc, 0.f) - log1pf(__expf(-fabsf(acc)));
                GA[(size_t)(r0 + tt) * 256 + tid] = __expf(ls * 0.0625f); }
        }
        __syncthreads();
    }
}

DEVINL void gla_item(const Params& P, int row0, int T, int h, int g, const float* s0, float* sout, int lane, int wave) {
    const half_t* Z = (const half_t*)(P.ws + WS_Z); const float* GA = (const float*)(P.ws + WS_GA); half_t* OG = (half_t*)(P.ws + WS_OG);
    const int col = g * 32 + wave * 4 + (lane >> 4), ks = lane & 15;
    float S[4];
#pragma unroll
    for (int e = 0; e < 4; ++e) S[e] = s0 ? s0[(size_t)(ks * 4 + e) * 128 + col] : 0.f;
    const half_t* zq = Z + (size_t)row0 * LDZ_AB + h * 64 + ks * 4; const half_t* zk = zq + 256; const half_t* zv = Z + (size_t)row0 * LDZ_AB + 512 + h * 128 + col;
    const float* ap = GA + (size_t)row0 * 256 + h * 64 + ks * 4;
    half_t* op = OG + (size_t)row0 * 512 + h * 128 + col;
    f32x4 ca[4], na[4]; h4 ck[4], cq[4], nk[4], nq[4]; half_t cv[4], nv[4];
#pragma unroll
    for (int u = 0; u < 4; ++u) { ca[u] = *(const f32x4*)(ap + (size_t)u * 256); ck[u] = *(const h4*)(zk + (size_t)u * LDZ_AB); cq[u] = *(const h4*)(zq + (size_t)u * LDZ_AB); cv[u] = zv[(size_t)u * LDZ_AB]; }
    for (int t0 = 0; t0 < T; t0 += 4) {
        if (t0 + 4 < T) {
#pragma unroll
            for (int u = 0; u < 4; ++u) { const size_t t = t0 + 4 + u; na[u] = *(const f32x4*)(ap + t * 256); nk[u] = *(const h4*)(zk + t * LDZ_AB); nq[u] = *(const h4*)(zq + t * LDZ_AB); nv[u] = zv[t * LDZ_AB]; }
        }
#pragma unroll
        for (int u = 0; u < 4; ++u) {
            const float v = (float)cv[u]; float o = 0.f;
#pragma unroll
            for (int e = 0; e < 4; ++e) { S[e] = S[e] * ca[u][e] + (float)ck[u][e] * v; o += S[e] * (float)cq[u][e]; }
            o = red16(o);
            if (ks == 0) op[(size_t)(t0 + u) * 512] = (half_t)(o * 0.125f);
        }
#pragma unroll
        for (int u = 0; u < 4; ++u) { ca[u] = na[u]; ck[u] = nk[u]; cq[u] = nq[u]; cv[u] = nv[u]; }
    }
#pragma unroll
    for (int e = 0; e < 4; ++e) sout[(size_t)(ks * 4 + e) * 128 + col] = S[e];
}
DEVINL void rwkv_item(const Params& P, int row0, int T, int h, int rg, const float* s0, float* sout, int lane, int wave) {
    const half_t* RPH = (const half_t*)(P.ws + WS_RPH); const float* RPW = (const float*)(P.ws + WS_RPW); half_t* YR = (half_t*)(P.ws + WS_YR);
    const int rv = rg * 32 + wave * 4 + (lane >> 4), ks = lane & 15;
    float S[4];
#pragma unroll
    for (int e = 0; e < 4; ++e) S[e] = s0 ? s0[(size_t)rv * 64 + ks * 4 + e] : 0.f;
    const half_t* rp = RPH + (size_t)row0 * 3072 + h * 64 + ks * 4;
    const half_t* vp = RPH + (size_t)row0 * 3072 + 1024 + h * 64 + rv;
    const float* wp = RPW + (size_t)row0 * 512 + h * 64 + ks * 4;
    half_t* yp = YR + (size_t)row0 * 512 + h * 64 + rv;
    f32x4 cw[4], nw[4]; h4 cr[4], ck[4], ckk[4], cb[4], nr[4], nk[4], nkk[4], nb[4]; half_t cv[4], nv[4];
#pragma unroll
    for (int u = 0; u < 4; ++u) { const size_t t = u; cw[u] = *(const f32x4*)(wp + t * 512); cr[u] = *(const h4*)(rp + t * 3072); ck[u] = *(const h4*)(rp + t * 3072 + 512); ckk[u] = *(const h4*)(rp + t * 3072 + 1536); cb[u] = *(const h4*)(rp + t * 3072 + 2048); cv[u] = vp[t * 3072]; }
    for (int t0 = 0; t0 < T; t0 += 4) {
        if (t0 + 4 < T) {
#pragma unroll
            for (int u = 0; u < 4; ++u) { const size_t t = t0 + 4 + u; nw[u] = *(const f32x4*)(wp + t * 512); nr[u] = *(const h4*)(rp + t * 3072); nk[u] = *(const h4*)(rp + t * 3072 + 512); nkk[u] = *(const h4*)(rp + t * 3072 + 1536); nb[u] = *(const h4*)(rp + t * 3072 + 2048); nv[u] = vp[t * 3072]; }
        }
#pragma unroll
        for (int u = 0; u < 4; ++u) {
            float sa = 0.f;
#pragma unroll
            for (int e = 0; e < 4; ++e) sa -= S[e] * (float)ckk[u][e];
            sa = red16(sa);
            const float v = (float)cv[u]; float y = 0.f;
#pragma unroll
            for (int e = 0; e < 4; ++e) { S[e] = S[e] * cw[u][e] + sa * (float)cb[u][e] + v * (float)ck[u][e]; y += S[e] * (float)cr[u][e]; }
            y = red16(y);
            if (ks == 0) yp[(size_t)(t0 + u) * 512] = (half_t)y;
        }
#pragma unroll
        for (int u = 0; u < 4; ++u) { cw[u] = nw[u]; cr[u] = nr[u]; ck[u] = nk[u]; ckk[u] = nkk[u]; cb[u] = nb[u]; cv[u] = nv[u]; }
    }
#pragma unroll
    for (int e = 0; e < 4; ++e) sout[(size_t)rv * 64 + ks * 4 + e] = S[e];
}
DEVINL void phase_scan_ab(const Params& P, int i, int lane, int wave, int G) {
    for (int it = blockIdx.x; it < 256 + 4096; it += G) {
        if (it < 128) { const int b = it >> 4, h = (it >> 2) & 3, g = it & 3;
            gla_item(P, b * TP, TP, h, g, nullptr, P.out + O_PGLA + (((size_t)i * NBP + b) * 4 + h) * 8192, lane, wave);
        } else if (it < 256) { const int x = it - 128, b = x >> 4, h = (x >> 1) & 7, rg = x & 1;
            rwkv_item(P, b * TP, TP, h, rg, nullptr, P.out + O_PRWKV + (((size_t)i * NBP + b) * 8 + h) * 4096, lane, wave);
        } else if (it < 256 + 2048) { const int x = it - 256, sb = x >> 4, h = (x >> 2) & 3, g = x & 3; const size_t so = (((size_t)i * NBS + sb) * 4 + h) * 8192;
            gla_item(P, NTP + sb * 4, 4, h, g, P.in[2] + so, P.out + O_SGLA + so, lane, wave);
        } else { const int x = it - 256 - 2048, sb = x >> 4, h = (x >> 1) & 7, rg = x & 1; const size_t so = (((size_t)i * NBS + sb) * 8 + h) * 4096;
            rwkv_item(P, NTP + sb * 4, 4, h, rg, P.in[3] + so, P.out + O_SRWKV + so, lane, wave);
        }
    }
}
DEVINL void phase_post_ab(const Params& P, int i, int gw, int ngw, int lane) {
    const half_t* Z = (const half_t*)(P.ws + WS_Z); const half_t* OG = (const half_t*)(P.ws + WS_OG); const half_t* YR = (const half_t*)(P.ws + WS_YR);
    const half_t* RPH = (const half_t*)(P.ws + WS_RPH); const float* BON = (const float*)(P.ws + WS_BON); half_t* MO = (half_t*)(P.ws + WS_MO);
    const float* ng = P.in[12] + i * 512; const float* lg = P.in[22] + i * 512; const float* lb = P.in[23] + i * 512;
    for (int row = gw; row < NT; row += ngw) {
#pragma unroll
        for (int h = 0; h < 4; ++h) {
            const int c = h * 128 + lane * 2;
            const h2 o = *(const h2*)(OG + (size_t)row * 512 + c); const float o0 = (float)o[0], o1 = (float)o[1];
            const float rs = rsqrtf(wave_sum(o0 * o0 + o1 * o1) * (1.f / 128.f) + 1e-6f);
            const h2 og = *(const h2*)(Z + (size_t)row * LDZ_AB + 1024 + c);
            h2 r; r[0] = (half_t)(o0 * rs * ng[c] * siluf_((float)og[0])); r[1] = (half_t)(o1 * rs * ng[c + 1] * siluf_((float)og[1]));
            *(h2*)(MO + (size_t)row * D + c) = r;
        }
#pragma unroll
        for (int h = 0; h < 8; ++h) {
            const int c = h * 64 + lane;
            const float y = (float)YR[(size_t)row * 512 + c];
            const float m = wave_sum(y) * (1.f / 64.f); const float d = y - m; const float var = wave_sum(d * d) * (1.f / 64.f);
            const float yn = d * rsqrtf(var + 64e-5f) * lg[c] + lb[c];
            const float v = (float)RPH[(size_t)row * 3072 + 1024 + c], gate = (float)RPH[(size_t)row * 3072 + 2560 + c];
            MO[(size_t)row * D + 512 + c] = (half_t)((yn + BON[(size_t)row * 8 + h] * v) * gate);
        }
    }
}

DEVINL void ld_h8f(const half_t* p, float (&o)[8]) { const h8 v = *(const h8*)p;
#pragma unroll
    for (int e = 0; e < 8; ++e) o[e] = (float)v[e]; }
DEVINL void ld_f8(const float* p, float (&o)[8]) { const f32x4 a = *(const f32x4*)p, b = *(const f32x4*)(p + 4); o[0] = a[0]; o[1] = a[1]; o[2] = a[2]; o[3] = a[3]; o[4] = b[0]; o[5] = b[1]; o[6] = b[2]; o[7] = b[3]; }
DEVINL void gdn_conv8(const half_t* zr, const float* cw, const float* cst, int t, int sb, int c, float (&o)[8]) {
    float x[8], w[8];
    ld_h8f(zr + c, x); ld_f8(cw + (size_t)3 * 3072 + c, w);
#pragma unroll
    for (int e = 0; e < 8; ++e) o[e] = w[e] * x[e];
#pragma unroll
    for (int d = 1; d < 4; ++d) {
        bool have = true;
        if (t >= d) ld_h8f(zr - (size_t)d * LDZ_C + c, x);
        else if (sb >= 0) ld_f8(cst + ((size_t)sb * 3 + (3 + t - d)) * 3072 + c, x);
        else have = false;
        if (have) { ld_f8(cw + (size_t)(3 - d) * 3072 + c, w);
#pragma unroll
            for (int e = 0; e < 8; ++e) o[e] += w[e] * x[e]; }
    }
#pragma unroll
    for (int e = 0; e < 8; ++e) o[e] = siluf_(o[e]);
}
DEVINL void phase_prep_c(const Params& P, int i, int gw, int ngw, int lane) {
    const half_t* Z = (const half_t*)(P.ws + WS_Z);
    half_t* GQ = (half_t*)(P.ws + WS_GQ); half_t* GK = (half_t*)(P.ws + WS_GK); half_t* GV = (half_t*)(P.ws + WS_GV); float* GS = (float*)(P.ws + WS_GS);
    const float* cw = P.in[26] + (size_t)i * 4 * 3072; const float* alog = P.in[27] + i * 8; const float* dtb = P.in[28] + i * 8; const float* cst = P.in[6] + (size_t)i * NBS * 3 * 3072;
    for (int row = gw; row < NT; row += ngw) {
        int t, sb; row_info(row, t, sb);
        const half_t* zr = Z + (size_t)row * LDZ_C;
#pragma unroll
        for (int hf = 0; hf < 2; ++hf) {
            const int c = hf * 512 + lane * 8;
            float q[8], k[8], v[8];
            gdn_conv8(zr, cw, cst, t, sb, c, q); gdn_conv8(zr, cw, cst, t, sb, 1024 + c, k); gdn_conv8(zr, cw, cst, t, sb, 2048 + c, v);
            float sq = 0.f, sk = 0.f;
#pragma unroll
            for (int e = 0; e < 8; ++e) { sq += q[e] * q[e]; sk += k[e] * k[e]; }
            sq = red16(sq); sk = red16(sk);
            const float qs = rsqrtf(sq + 1e-6f) * 0.08838834764831845f, kss = rsqrtf(sk + 1e-6f);
            float qk = 0.f; h8 qo, ko, vo;
#pragma unroll
            for (int e = 0; e < 8; ++e) { q[e] *= qs; k[e] *= kss; qk += q[e] * k[e]; qo[e] = (half_t)q[e]; ko[e] = (half_t)k[e]; vo[e] = (half_t)v[e]; }
            qk = red16(qk);
            *(h8*)(GQ + (size_t)row * 1024 + c) = qo; *(h8*)(GK + (size_t)row * 1024 + c) = ko; *(h8*)(GV + (size_t)row * 1024 + c) = vo;
            if ((lane & 15) == 0) {
                const int h = hf * 4 + (lane >> 4);
                const float bl = (float)zr[4096 + h], al = (float)zr[4104 + h];
                const float x = al + dtb[h]; const float sp = x > 20.f ? x : log1pf(__expf(x));
                const float g = -__expf(alog[h]) * sp;
                *(f32x4*)(GS + ((size_t)row * 8 + h) * 4) = (f32x4){sigmoidf_(bl), __expf(g), qk, 0.f};
            }
        }
    }
    for (int q = gw; q < NSEQ * 3; q += ngw) {
        const int s = q / 3, j = q - s * 3;
        const int row = s < NBP ? s * TP + TP - 3 + j : NTP + (s - NBP) * 4 + 1 + j;
        float* dst = s < NBP ? P.out + O_PGDNCONV + (((size_t)i * NBP + s) * 3 + j) * 3072 : P.out + O_SGDNCONV + (((size_t)i * NBS + (s - NBP)) * 3 + j) * 3072;
        for (int p = 0; p < 12; ++p) { const int c = p * 256 + lane * 4; *(f32x4*)(dst + c) = ld_h4(Z + (size_t)row * LDZ_C + c); }
    }
}
DEVINL void gdn_item(const Params& P, int row0, int T, int h, int g, const float* s0, float* sout, int lane, int wave) {
    const half_t* GQ = (const half_t*)(P.ws + WS_GQ); const half_t* GK = (const half_t*)(P.ws + WS_GK); const half_t* GV = (const half_t*)(P.ws + WS_GV); const float* GS = (const float*)(P.ws + WS_GS);
    half_t* OD = (half_t*)(P.ws + WS_OD);
    const int col = g * 32 + wave * 4 + (lane >> 4), ks = lane & 15;
    float S[8];
#pragma unroll
    for (int e = 0; e < 8; ++e) S[e] = s0 ? s0[(size_t)(ks * 8 + e) * 128 + col] : 0.f;
    const half_t* qp = GQ + (size_t)row0 * 1024 + h * 128 + ks * 8; const half_t* kp = GK + (size_t)row0 * 1024 + h * 128 + ks * 8; const half_t* vp = GV + (size_t)row0 * 1024 + h * 128 + col;
    const float* sp = GS + ((size_t)row0 * 8 + h) * 4;
    half_t* op = OD + (size_t)row0 * 1024 + h * 128 + col;
    h8 cq[4], ck[4], nq[4], nk[4]; half_t cv[4], nv[4]; f32x4 cs[4], ns[4];
#pragma unroll
    for (int u = 0; u < 4; ++u) { const size_t t = u; cq[u] = *(const h8*)(qp + t * 1024); ck[u] = *(const h8*)(kp + t * 1024); cv[u] = vp[t * 1024]; cs[u] = *(const f32x4*)(sp + t * 32); }
    for (int t0 = 0; t0 < T; t0 += 4) {
        if (t0 + 4 < T) {
#pragma unroll
            for (int u = 0; u < 4; ++u) { const size_t t = t0 + 4 + u; nq[u] = *(const h8*)(qp + t * 1024); nk[u] = *(const h8*)(kp + t * 1024); nv[u] = vp[t * 1024]; ns[u] = *(const f32x4*)(sp + t * 32); }
        }
#pragma unroll
        for (int u = 0; u < 4; ++u) {
            float d1 = 0.f, d2 = 0.f;
#pragma unroll
            for (int e = 0; e < 8; ++e) { d1 += S[e] * (float)ck[u][e]; d2 += S[e] * (float)cq[u][e]; }
            d1 = red16(d1); d2 = red16(d2);
            const float beta = cs[u][0], eg = cs[u][1], qk = cs[u][2];
            const float uu = beta * ((float)cv[u] - eg * d1);
#pragma unroll
            for (int e = 0; e < 8; ++e) S[e] = eg * S[e] + (float)ck[u][e] * uu;
            if (ks == 0) op[(size_t)(t0 + u) * 1024] = (half_t)(eg * d2 + qk * uu);
        }
#pragma unroll
        for (int u = 0; u < 4; ++u) { cq[u] = nq[u]; ck[u] = nk[u]; cv[u] = nv[u]; cs[u] = ns[u]; }
    }
#pragma unroll
    for (int e = 0; e < 8; ++e) sout[(size_t)(ks * 8 + e) * 128 + col] = S[e];
}
DEVINL void phase_scan_c(const Params& P, int i, int lane, int wave, int G) {
    for (int it = blockIdx.x; it < 256 + 4096; it += G) {
        if (it < 256) { const int b = it >> 5, h = (it >> 2) & 7, g = it & 3;
            gdn_item(P, b * TP, TP, h, g, nullptr, P.out + O_PGDN + (((size_t)i * NBP + b) * 8 + h) * 16384, lane, wave);
        } else { const int x = it - 256, sb = x >> 5, h = (x >> 2) & 7, g = x & 3; const size_t so = (((size_t)i * NBS + sb) * 8 + h) * 16384;
            gdn_item(P, NTP + sb * 4, 4, h, g, P.in[5] + so, P.out + O_SGDN + so, lane, wave);
        }
    }
}
DEVINL void phase_post_c(const Params& P, int i, int gw, int ngw, int lane) {
    const half_t* Z = (const half_t*)(P.ws + WS_Z); const half_t* OD = (const half_t*)(P.ws + WS_OD); half_t* MO = (half_t*)(P.ws + WS_MO);
    const float* ng = P.in[29] + i * 128;
    const float g0 = ng[lane * 2], g1 = ng[lane * 2 + 1];
    for (int row = gw; row < NT; row += ngw) {
#pragma unroll
        for (int h = 0; h < 8; ++h) {
            const int c = h * 128 + lane * 2;
            const h2 o = *(const h2*)(OD + (size_t)row * 1024 + c); const float o0 = (float)o[0], o1 = (float)o[1];
            const float rs = rsqrtf(wave_sum(o0 * o0 + o1 * o1) * (1.f / 128.f) + 1e-6f);
            const h2 zg = *(const h2*)(Z + (size_t)row * LDZ_C + 3072 + c);
            h2 r; r[0] = (half_t)(o0 * rs * g0 * siluf_((float)zg[0])); r[1] = (half_t)(o1 * rs * g1 * siluf_((float)zg[1]));
            *(h2*)(MO + (size_t)row * D + c) = r;
        }
    }
}

constexpr int N_PHASES = 41;
__global__ void __launch_bounds__(NTHREADS, 2) mega_fwd(Params P) {
    extern __shared__ __attribute__((aligned(16))) unsigned char lds_raw[];
    LAS unsigned char* lds = (LAS unsigned char*)lds_raw;
    const int G = gridDim.x;
#if !MK_MULTI
    cg::grid_group grid = cg::this_grid();
#define SEAM(k) do { if ((k) + 1 < P.ph_hi) grid.sync(); } while (0)
#else
#define SEAM(k) do { } while (0)
#endif
#define IN(k) (P.ph_lo <= (k) && (k) < P.ph_hi)
#define PHASE_LOCALS() int tid = threadIdx.x, bid = blockIdx.x; asm volatile("" : "+v"(tid), "+s"(bid)); (void)bid; \
    const int lane = tid & 63, wave = __builtin_amdgcn_readfirstlane(tid >> 6), gw = bid * NWAVES + wave, ngw = G * NWAVES; (void)lane; (void)gw; (void)ngw;
    { PHASE_LOCALS();
      if (IN(0)) { phase_prologue(P, gw, ngw, lane); convert_layer_weights(P, 0, lds, gw, ngw, lane, wave); SEAM(0); } }
#pragma unroll 1
    for (int l = 0; l < 4; ++l) {
        const int base = 1 + l * 10, i = l >> 1; const bool even = (l & 1) == 0;
        const int ldz = even ? LDZ_AB : LDZ_C;
        { PHASE_LOCALS();
        if (IN(base + 0)) {
            pg8::Gemm g{(half_t*)(P.ws + WS_XB), (half_t*)(P.ws + WS_WIN), MP, ldz, D}; pg8::StaticOrder S; S.init(MP, ldz, G, bid);
            pg8::EpiZ E{(half_t*)(P.ws + WS_Z), ldz};
            pg8::gemm_phase<pg8::EpiZ, pg8::StaticOrder, true, true>(lds, g, S, E, tid);
            SEAM(base + 0);
        } }
        { PHASE_LOCALS(); if (IN(base + 1)) { if (even) phase_prep_ab(P, i, lds, tid, lane, wave, G); else phase_prep_c(P, i, gw, ngw, lane); SEAM(base + 1); } }
        { PHASE_LOCALS(); if (IN(base + 2)) { if (even) phase_scan_ab(P, i, lane, wave, G); else phase_scan_c(P, i, lane, wave, G); SEAM(base + 2); } }
        { PHASE_LOCALS(); if (IN(base + 3)) { if (even) phase_post_ab(P, i, gw, ngw, lane); else phase_post_c(P, i, gw, ngw, lane); SEAM(base + 3); } }
        { PHASE_LOCALS();
        if (IN(base + 4)) {
            pg8::Gemm g{(half_t*)(P.ws + WS_MO), (half_t*)(P.ws + WS_WOUT), MP, D, D}; pg8::StaticOrder S; S.init(MP, D, G, bid);
            pg8::EpiRes E{(float*)(P.ws + WS_X), ALPHA};
            pg8::gemm_phase<pg8::EpiRes, pg8::StaticOrder, true, true>(lds, g, S, E, tid);
            SEAM(base + 4);
        } }
        { PHASE_LOCALS(); if (IN(base + 5)) { phase_ln(P, P.in[35] + l * D, P.in[36] + l * D, false, -1, gw, ngw, lane); SEAM(base + 5); } }
        { PHASE_LOCALS();
        if (IN(base + 6)) {
            pg8::Gemm g{(half_t*)(P.ws + WS_XB), (half_t*)(P.ws + WS_WUP), MP, LDH, D}; pg8::StaticOrder S; S.init(MP, LDH, G, bid);
            pg8::EpiZ E{(half_t*)(P.ws + WS_Z), LDH};
            pg8::gemm_phase<pg8::EpiZ, pg8::StaticOrder, true, true>(lds, g, S, E, tid);
            SEAM(base + 6);
        } }
        { PHASE_LOCALS(); if (IN(base + 7)) { phase_act(P, l, gw, ngw, lane); SEAM(base + 7); } }
        { PHASE_LOCALS();
        if (IN(base + 8)) {
            pg8::Gemm g{(half_t*)(P.ws + WS_MO), (half_t*)(P.ws + WS_WDN), MP, D, DFF}; pg8::StaticOrder S; S.init(MP, D, G, bid);
            pg8::EpiRes E{(float*)(P.ws + WS_X), ALPHA};
            pg8::gemm_phase<pg8::EpiRes, pg8::StaticOrder, true, true>(lds, g, S, E, tid);
            SEAM(base + 8);
        } }
        { PHASE_LOCALS();
        if (IN(base + 9)) {
            phase_ln(P, P.in[37] + l * D, P.in[38] + l * D, l == 3, l == 1 ? 1 : -1, gw, ngw, lane);
            if (l < 3) convert_layer_weights(P, l + 1, lds, gw, ngw, lane, wave);
            SEAM(base + 9);
        } }
    }
#undef IN
#undef SEAM
}

extern "C" void kernel_launch(void* const* d_in, const int* in_sizes, int n_in, void* d_out, int out_size, void* d_ws, size_t ws_size, hipStream_t stream) {
    static int grid = 0;
    if (grid == 0) {
        if (n_in != 39 || (size_t)out_size != O_END || ws_size < WS_END) { fprintf(stderr, "kernel_launch: unexpected problem (n_in %d, out %d, ws %zu); nothing launched\n", n_in, out_size, ws_size); grid = -1; return; }
        int dev = 0, cus = 0, per_cu = 0;
        if (hipGetDevice(&dev) != hipSuccess || hipDeviceGetAttribute(&cus, hipDeviceAttributeMultiprocessorCount, dev) != hipSuccess) { grid = -1; return; }
        if (hipFuncSetAttribute((const void*)mega_fwd, hipFuncAttributeMaxDynamicSharedMemorySize, LDS_BYTES) != hipSuccess) { fprintf(stderr, "kernel_launch: hipFuncSetAttribute failed\n"); grid = -1; return; }
        if (hipOccupancyMaxActiveBlocksPerMultiprocessor(&per_cu, (const void*)mega_fwd, NTHREADS, LDS_BYTES) != hipSuccess || per_cu < 1) { fprintf(stderr, "kernel_launch: occupancy query says %d blocks per CU\n", per_cu); (void)hipGetLastError(); grid = -1; return; }
        grid = cus;
    }
    if (grid < 0) return;
    Params p{};
    for (int k = 0; k < 39; ++k) p.in[k] = (const float*)d_in[k];
    p.out = (float*)d_out; p.ws = (unsigned char*)d_ws;
#if MK_MULTI
    for (int k = 0; k < N_PHASES; ++k) { p.ph_lo = k; p.ph_hi = k + 1; hipLaunchKernelGGL(mega_fwd, dim3(grid), dim3(NTHREADS), LDS_BYTES, stream, p); }
#else
    p.ph_lo = 0; p.ph_hi = N_PHASES;
    void* args[] = {&p};
    const hipError_t e = hipLaunchCooperativeKernel((const void*)mega_fwd, dim3(grid), dim3(NTHREADS), args, LDS_BYTES, stream);
    if (e != hipSuccess) fprintf(stderr, "kernel_launch: cooperative launch failed: %s (grid %d)\n", hipGetErrorString(e), grid);
#endif
}
```

```cpp
#include <hip/hip_runtime.h>
#include <hip/hip_cooperative_groups.h>
#include <cstdio>
#include <cstdint>
namespace cg = cooperative_groups;

#ifndef MK_MULTI
#define MK_MULTI 0
#endif

namespace pg8 {
#define PG8_LAS __attribute__((address_space(3)))
typedef _Float16 bf16_t;
typedef _Float16 bf16x8 __attribute__((ext_vector_type(8)));
typedef float f32x4 __attribute__((ext_vector_type(4)));
typedef unsigned u32x4 __attribute__((ext_vector_type(4)));
constexpr int BM = 256, BK = 64, HALF = 128, HTB = HALF * BK * 2  , STAGE_BYTES = 8 * HTB, NXCD = 8, WGM = 8;

__host__ __device__ __forceinline__ int lds_byte(int r, int c) { const int st = (r >> 4) * 2 + (c >> 5), rr = r & 15, cc = c & 31, ob = rr * 64 + cc * 2; return st * 1024 + (ob ^ (((ob >> 9) & 1) << 5)); }
__host__ __device__ __forceinline__ void stage_rc(int b, int& R, int& C) { const int st = b / 1024, sb = b % 1024, swz = sb ^ (((sb >> 9) & 1) << 5); R = (st >> 1) * 16 + swz / 64; C = (st & 1) * 32 + (swz % 64) / 2; }
__host__ __device__ __forceinline__ int perm32(int rho) { const int n = rho >> 4, i = rho & 15; return 8 * (i >> 2) + 4 * n + (i & 3); }

struct Unit { int pm, pn, kt0, nkt, part; };
struct Gemm { const bf16_t* A; const bf16_t* Bt; int M, N, K; };

struct StaticOrder {
    int nM, nN, nwg, G, c, nkt;
    __host__ __device__ __forceinline__ void init(int M, int N, int G_, int c_, int K_ = 1024) { nM = M / BM; nN = N / BM; nwg = nM * nN; G = G_; c = c_; nkt = K_ / BK; }
    __host__ __device__ __forceinline__ bool next(int i, Unit& u) const {
        const long L = (long)i * G + c; if (L >= nwg) return false;
        int wgid = (int)L; { const int q = nwg / NXCD, r = nwg % NXCD, xcd = wgid % NXCD, off = wgid / NXCD; wgid = (xcd < r ? xcd * (q + 1) : r * (q + 1) + (xcd - r) * q) + off; }
        const int nig = WGM * nN, gid = wgid / nig, fm = gid * WGM, gsz = (nM - fm) < WGM ? (nM - fm) : WGM;
        u.pm = fm + ((wgid % nig) % gsz); u.pn = (wgid % nig) / gsz; u.kt0 = 0; u.nkt = nkt; u.part = 0; return true;
    }
    __device__ __forceinline__ void a_ready(const Unit&) const {}
    __device__ __forceinline__ void done(const Unit&) const {}
};
struct SplitOrder {
    StaticOrder S0; int c, nkt, pk, ppu, npieces;
    __host__ __device__ __forceinline__ void init(int K, int G_, int c_) { S0.init(16384, 1024, G_, c_, K); c = c_; nkt = K / BK; pk = (nkt % 4 == 0 && nkt > 16) ? 4 : 2; ppu = nkt / pk; npieces = 12 * ppu; }
    __host__ __device__ __forceinline__ bool next(int i, Unit& u) const {
        if (i == 0) return S0.next(0, u);
        if (i == 1 && c < npieces) { const int lu = c / ppu, p = c - lu * ppu; u.pm = 64 + (lu >> 2); u.pn = lu & 3; u.kt0 = p * pk; u.nkt = pk; u.part = 1; return true; }
        return false;
    }
    __device__ __forceinline__ void a_ready(const Unit&) const {}
    __device__ __forceinline__ void done(const Unit&) const {}
};

struct EpiZ {
    static constexpr bool PERM = true, AFTER_DRAIN = false;
    bf16_t* O; int ldc;
    __device__ __forceinline__ void operator()(const f32x4 (&acc)[2][2][4][2], const Unit& u, int wr, int wc, int fr, int fq) const {
        const int row0 = u.pm * BM + wr * 64 + fr, col0 = u.pn * BM + wc * 32 + 8 * fq;
#pragma unroll
        for (int ai = 0; ai < 2; ++ai)
#pragma unroll
            for (int m = 0; m < 4; ++m) { bf16_t* rowp = O + (size_t)(row0 + ai * HALF + m * 16) * ldc + col0;
#pragma unroll
                for (int bj = 0; bj < 2; ++bj) { const f32x4 v0 = acc[ai][bj][m][0], v1 = acc[ai][bj][m][1];
                    bf16x8 w; w[0] = (bf16_t)v0[0]; w[1] = (bf16_t)v0[1]; w[2] = (bf16_t)v0[2]; w[3] = (bf16_t)v0[3]; w[4] = (bf16_t)v1[0]; w[5] = (bf16_t)v1[1]; w[6] = (bf16_t)v1[2]; w[7] = (bf16_t)v1[3];
                    *(bf16x8*)(rowp + bj * HALF) = w; } }
    }
};
struct EpiRes {
    static constexpr bool PERM = false, AFTER_DRAIN = false;
    float* X; float alpha; float* XACC;
    __device__ __forceinline__ void operator()(const f32x4 (&acc)[2][2][4][2], const Unit& u, int wr, int wc, int fr, int fq) const {
        const int col0 = u.pn * BM + wc * 32 + 4 * fq;
        if (u.part) {
            const int row0 = (u.pm - 64) * BM + wr * 64 + fr;
#pragma unroll
            for (int ai = 0; ai < 2; ++ai)
#pragma unroll
                for (int m = 0; m < 4; ++m) { float* rowp = XACC + (size_t)(row0 + ai * HALF + m * 16) * 1024 + col0;
#pragma unroll
                    for (int bj = 0; bj < 2; ++bj)
#pragma unroll
                        for (int n = 0; n < 2; ++n) { float* p = rowp + bj * HALF + n * 16; const f32x4 v = acc[ai][bj][m][n];
                            unsafeAtomicAdd(p, v[0]); unsafeAtomicAdd(p + 1, v[1]); unsafeAtomicAdd(p + 2, v[2]); unsafeAtomicAdd(p + 3, v[3]); } }
            return;
        }
        const int row0 = u.pm * BM + wr * 64 + fr;
#pragma unroll
        for (int ai = 0; ai < 2; ++ai)
#pragma unroll
            for (int m = 0; m < 4; ++m) { float* rowp = X + (size_t)(row0 + ai * HALF + m * 16) * 1024 + col0;
#pragma unroll
                for (int bj = 0; bj < 2; ++bj)
#pragma unroll
                    for (int n = 0; n < 2; ++n) { f32x4* p = (f32x4*)(rowp + bj * HALF + n * 16); const f32x4 x = *p; *p = x * alpha + acc[ai][bj][m][n]; } }
    }
};

template <class Epi, class Sched, bool ALIGN_EPI = false, bool SP2 = false>
__device__ __forceinline__ void gemm_phase(PG8_LAS unsigned char* lds, const Gemm g, const Sched& S, const Epi& E, const int tid) {
    const int wid = __builtin_amdgcn_readfirstlane(tid >> 6), lane = tid & 63, wr = wid >> 2, wc = wid & 3, fr = lane & 15, fq = lane >> 4;
    const int K = g.K;
    unsigned voffA[2], voffB[2];
#pragma unroll
    for (int i = 0; i < 2; ++i) { int R, C; stage_rc(tid * 16 + i * 8192, R, C); const int Rb = Epi::PERM ? ((R & ~31) + perm32(R & 31)) : R;
        voffA[i] = (unsigned)(R * K + C) * 2u; voffB[i] = (unsigned)(Rb * K + C) * 2u; }
    const size_t kstep = (size_t)(BK * 2);
    const size_t hstep = (size_t)HALF * K * 2;
    const size_t tstep = 2 * hstep;
    const unsigned ldsw = (unsigned)wid * 1024u;
    const int aoff = lds_byte(wr * 64 + fr, fq * 8), boff = lds_byte(wc * 32 + fr, fq * 8);
#define PG8_SA(b, h) (((b) * 2 + (h)) * HTB)
#define PG8_SB(b, h) ((4 + (b) * 2 + (h)) * HTB)
#define PG8_STAGE(bufoff, gbase, voff) do { _Pragma("unroll") for (int _i = 0; _i < 2; ++_i) \
        __builtin_amdgcn_global_load_lds((const unsigned*)((const char*)(gbase) + (voff)[_i]), (PG8_LAS unsigned*)(lds + (bufoff) + ldsw + _i * 8192), 16, 0, 0); } while (0)
#define PG8_LDA(dst, b, h) do { _Pragma("unroll") for (int m = 0; m < 4; ++m) _Pragma("unroll") for (int k = 0; k < 2; ++k) dst[m][k] = *(const PG8_LAS bf16x8*)(lds + PG8_SA(b, h) + aoff + m * 2048 + k * 1024); } while (0)
#define PG8_LDB(dst, b, h) do { _Pragma("unroll") for (int n = 0; n < 2; ++n) _Pragma("unroll") for (int k = 0; k < 2; ++k) dst[n][k] = *(const PG8_LAS bf16x8*)(lds + PG8_SB(b, h) + boff + n * 2048 + k * 1024); } while (0)
#define PG8_MMA(ai, bj, At, Bt) do { __builtin_amdgcn_s_setprio(1); _Pragma("unroll") for (int m = 0; m < 4; ++m) _Pragma("unroll") for (int n = 0; n < 2; ++n) _Pragma("unroll") for (int k = 0; k < 2; ++k) \
        acc[ai][bj][m][n] = __builtin_amdgcn_mfma_f32_16x16x32_f16(Bt[n][k], At[m][k], acc[ai][bj][m][n], 0, 0, 0); __builtin_amdgcn_s_setprio(0); } while (0)
#define PG8_WAIT_V(n) asm volatile("s_waitcnt vmcnt(" #n ")" ::: "memory")
#define PG8_WAIT_L(n) asm volatile("s_waitcnt lgkmcnt(" #n ")" ::: "memory")
#define PG8_BAR __builtin_amdgcn_s_barrier()
#define PG8_SCHED __builtin_amdgcn_sched_barrier(0)
    Unit cur, nxt; int ui = 0;
    if (!S.next(0, cur)) return;
    f32x4 acc[2][2][4][2];
#pragma unroll
    for (int a = 0; a < 2; ++a)
#pragma unroll
        for (int b = 0; b < 2; ++b)
#pragma unroll
            for (int m = 0; m < 4; ++m)
#pragma unroll
                for (int n = 0; n < 2; ++n) acc[a][b][m][n] = (f32x4){0.f, 0.f, 0.f, 0.f};
    bf16x8 At[4][2], B0[2][2], B1[2][2];
    const char* cA = (const char*)g.A + (size_t)cur.pm * tstep + (size_t)cur.kt0 * kstep; const char* cB = (const char*)g.Bt + (size_t)cur.pn * tstep + (size_t)cur.kt0 * kstep;
    S.a_ready(cur);
    if constexpr (SP2) {
        PG8_STAGE(PG8_SB(0, 0), cB, voffB); PG8_STAGE(PG8_SB(0, 1), cB + hstep, voffB); PG8_STAGE(PG8_SA(0, 0), cA, voffA); PG8_STAGE(PG8_SA(0, 1), cA + hstep, voffA);
        if (wr == 1) PG8_BAR;
        PG8_WAIT_V(2); PG8_BAR;
        PG8_STAGE(PG8_SB(1, 0), cB + kstep, voffB); PG8_STAGE(PG8_SA(1, 0), cA + kstep, voffA); PG8_STAGE(PG8_SB(1, 1), cB + hstep + kstep, voffB);
        PG8_WAIT_V(6); PG8_BAR;
    } else {
        PG8_STAGE(PG8_SB(0, 0), cB, voffB); PG8_STAGE(PG8_SA(0, 0), cA, voffA); PG8_STAGE(PG8_SB(0, 1), cB + hstep, voffB); PG8_STAGE(PG8_SA(0, 1), cA + hstep, voffA);
        if (wr == 1) PG8_BAR;
        PG8_WAIT_V(4); PG8_BAR;
        PG8_STAGE(PG8_SB(1, 0), cB + kstep, voffB); PG8_STAGE(PG8_SA(1, 0), cA + kstep, voffA); PG8_STAGE(PG8_SB(1, 1), cB + hstep + kstep, voffB);
        PG8_WAIT_V(6); PG8_BAR;
    }
    for (;;) {
        const bool has_next = S.next(ui + 1, nxt);
        const char* nA = has_next ? (const char*)g.A + (size_t)nxt.pm * tstep + (size_t)nxt.kt0 * kstep : cA; const char* nB = has_next ? (const char*)g.Bt + (size_t)nxt.pn * tstep + (size_t)nxt.kt0 * kstep : cB;
        const int nt = cur.nkt;
        for (int t = 0; t < nt; t += 2) {
            const bool last = (t == nt - 2);
            const char* a1 = cA + (size_t)(t + 1) * kstep;
            const char* a2 = last ? nA : cA + (size_t)(t + 2) * kstep; const char* b2 = last ? nB : cB + (size_t)(t + 2) * kstep;
            const char* a3 = a2 + kstep; const char* b3 = b2 + kstep;
            if (last && has_next) S.a_ready(nxt);
            if constexpr (SP2) {
            PG8_LDB(B0, 0, 0); PG8_LDB(B1, 0, 1); PG8_SCHED; PG8_LDA(At, 0, 0); PG8_STAGE(PG8_SA(1, 1), a1 + hstep, voffA);
            PG8_WAIT_V(8); PG8_WAIT_L(0); PG8_BAR; PG8_MMA(0, 0, At, B0); PG8_MMA(0, 1, At, B1); PG8_BAR; PG8_SCHED;
            PG8_LDA(At, 0, 1); PG8_STAGE(PG8_SB(0, 0), b2, voffB); PG8_STAGE(PG8_SB(0, 1), b2 + hstep, voffB); PG8_STAGE(PG8_SA(0, 0), a2, voffA);
            PG8_WAIT_V(8); PG8_WAIT_L(0); PG8_BAR; PG8_MMA(1, 0, At, B0); PG8_MMA(1, 1, At, B1); PG8_BAR; PG8_SCHED;
            PG8_LDB(B0, 1, 0); PG8_LDB(B1, 1, 1); PG8_SCHED; PG8_LDA(At, 1, 0); PG8_STAGE(PG8_SA(0, 1), a2 + hstep, voffA);
            PG8_WAIT_V(8); PG8_WAIT_L(0); PG8_BAR; PG8_MMA(0, 0, At, B0); PG8_MMA(0, 1, At, B1); PG8_BAR; PG8_SCHED;
            PG8_LDA(At, 1, 1); PG8_STAGE(PG8_SB(1, 0), b3, voffB); PG8_STAGE(PG8_SB(1, 1), b3 + hstep, voffB); PG8_STAGE(PG8_SA(1, 0), a3, voffA);
            PG8_WAIT_V(8); PG8_WAIT_L(0); PG8_BAR; PG8_MMA(1, 0, At, B0); PG8_MMA(1, 1, At, B1); PG8_BAR; PG8_SCHED;
            } else {
            PG8_LDB(B0, 0, 0); PG8_SCHED; PG8_LDA(At, 0, 0); PG8_STAGE(PG8_SA(1, 1), a1 + hstep, voffA);
            PG8_WAIT_L(8); PG8_BAR; PG8_WAIT_L(0); PG8_MMA(0, 0, At, B0); PG8_BAR; PG8_SCHED;
            PG8_LDB(B1, 0, 1); PG8_STAGE(PG8_SB(0, 0), b2, voffB);
            PG8_BAR; PG8_WAIT_L(0); PG8_MMA(0, 1, At, B1); PG8_BAR;
            PG8_LDA(At, 0, 1); PG8_STAGE(PG8_SA(0, 0), a2, voffA);
            PG8_BAR; PG8_WAIT_L(0); PG8_MMA(1, 0, At, B0); PG8_BAR; PG8_SCHED;
            PG8_STAGE(PG8_SB(0, 1), b2 + hstep, voffB);
            PG8_WAIT_V(6); PG8_BAR; PG8_MMA(1, 1, At, B1); PG8_BAR;
            PG8_LDB(B0, 1, 0); PG8_SCHED; PG8_LDA(At, 1, 0); PG8_STAGE(PG8_SA(0, 1), a2 + hstep, voffA);
            PG8_WAIT_L(8); PG8_BAR; PG8_WAIT_L(0); PG8_MMA(0, 0, At, B0); PG8_BAR; PG8_SCHED;
            PG8_LDB(B1, 1, 1); PG8_STAGE(PG8_SB(1, 0), b3, voffB);
            PG8_BAR; PG8_WAIT_L(0); PG8_MMA(0, 1, At, B1); PG8_BAR;
            PG8_LDA(At, 1, 1); PG8_STAGE(PG8_SA(1, 0), a3, voffA);
            PG8_BAR; PG8_WAIT_L(0); PG8_MMA(1, 0, At, B0); PG8_BAR; PG8_SCHED;
            PG8_STAGE(PG8_SB(1, 1), b3 + hstep, voffB);
            PG8_WAIT_V(6); PG8_BAR; PG8_MMA(1, 1, At, B1); PG8_BAR;
            }
        }
        if constexpr (ALIGN_EPI) { if (wr == 0) PG8_BAR; }
        if constexpr (!Epi::AFTER_DRAIN) { E(acc, cur, wr, wc, fr, fq); S.done(cur); }
        if (!has_next) break;
#pragma unroll
        for (int a = 0; a < 2; ++a)
#pragma unroll
            for (int b = 0; b < 2; ++b)
#pragma unroll
                for (int m = 0; m < 4; ++m)
#pragma unroll
                    for (int n = 0; n < 2; ++n) acc[a][b][m][n] = (f32x4){0.f, 0.f, 0.f, 0.f};
        cur = nxt; cA = nA; cB = nB; ++ui;
        if constexpr (ALIGN_EPI) { if (wr == 1) PG8_BAR; }
    }
    PG8_WAIT_V(0);
    if constexpr (!ALIGN_EPI) { if (wr == 0) PG8_BAR; }
    PG8_BAR;
    if constexpr (Epi::AFTER_DRAIN) { E.fused(acc, cur, wr, wc, fr, fq, lds, wid, lane); S.done(cur); }
#undef PG8_SA
#undef PG8_SB
#undef PG8_STAGE
#undef PG8_LDA
#undef PG8_LDB
#undef PG8_MMA
#undef PG8_WAIT_V
#undef PG8_WAIT_L
#undef PG8_BAR
#undef PG8_SCHED
}
}

#define LAS __attribute__((address_space(3)))
#define DEVINL __device__ __forceinline__
typedef _Float16 half_t;
typedef _Float16 h8 __attribute__((ext_vector_type(8)));
typedef _Float16 h4 __attribute__((ext_vector_type(4)));
typedef _Float16 h2 __attribute__((ext_vector_type(2)));
typedef float f32x4 __attribute__((ext_vector_type(4)));
typedef float f32x2 __attribute__((ext_vector_type(2)));

#ifndef PROBE_MASK
#define PROBE_MASK 0
#endif
#define REP(k) for (int rep_ = 0; rep_ < 1 + ((PROBE_MASK >> (k)) & 1); ++rep_)
constexpr int NWAVES = 8, NTHREADS = 512;
constexpr int D = 1024, TP = 2064, NBP = 8, NTP = NBP * TP, NBS = 128, TSS = 4, NTS = NBS * TSS, NT = NTP + NTS, MP = 17152;
static_assert(NTP == 16512 && NT == 17024 && MP % 256 == 0 && MP >= NT + NBS, "rows");
constexpr int LDZ_AB = 3584, LDZ_C = 4352, DFF = 2816, LDH = 2 * DFF;
constexpr int ZR = 1792;
constexpr float ALPHA = 1.6817928305074292f;
constexpr int NSEQ = NBP + NBS;

constexpr size_t O_YP = 0, O_YS = O_YP + (size_t)NBP * 2048 * D, O_PGLA = O_YS + (size_t)NTS * D, O_PRWKV = O_PGLA + (size_t)2 * 8 * 4 * 64 * 128,
    O_PSHIFT = O_PRWKV + (size_t)2 * 8 * 8 * 64 * 64, O_PGDN = O_PSHIFT + (size_t)2 * 8 * D, O_PGDNCONV = O_PGDN + (size_t)2 * 8 * 8 * 128 * 128,
    O_PFFNCONV = O_PGDNCONV + (size_t)2 * 8 * 3 * 3072, O_SGLA = O_PFFNCONV + (size_t)4 * 8 * 2 * DFF, O_SRWKV = O_SGLA + (size_t)2 * 128 * 4 * 64 * 128,
    O_SSHIFT = O_SRWKV + (size_t)2 * 128 * 8 * 64 * 64, O_SGDN = O_SSHIFT + (size_t)2 * 128 * D, O_SGDNCONV = O_SGDN + (size_t)2 * 128 * 8 * 128 * 128,
    O_SFFNCONV = O_SGDNCONV + (size_t)2 * 128 * 3 * 3072, O_END = O_SFFNCONV + (size_t)4 * 128 * 2 * DFF;
static_assert(O_END == 76627968, "output size");

constexpr size_t MiB = 1u << 20;
constexpr size_t WS_WIN = 1 * MiB, WS_WOUT = 10 * MiB, WS_WUP = 12 * MiB, WS_WDN = 23 * MiB;
constexpr size_t WS_W2T = 29 * MiB, WS_A2T = WS_W2T + 65536, WS_G2T = WS_A2T + 65536, WS_GW2T = WS_G2T + 131072;
constexpr size_t WS_X = 32 * MiB, WS_XB = 100 * MiB, WS_MO = 134 * MiB  , WS_FREE = 168 * MiB, WS_BIG = 227 * MiB;
constexpr size_t WS_GA = WS_FREE, WS_OG = WS_FREE + 17 * MiB, WS_YR = WS_FREE + 34 * MiB;
constexpr size_t WS_OD = WS_FREE;
constexpr size_t WS_Z = WS_BIG;
constexpr size_t WS_RPH = WS_BIG + 119 * MiB, WS_RPW = WS_BIG + 219 * MiB, WS_BON = WS_BIG + 253 * MiB;
constexpr size_t WS_GQ = WS_BIG + 143 * MiB, WS_GK = WS_GQ + 34 * MiB, WS_GV = WS_GK + 34 * MiB, WS_GS = WS_GV + 34 * MiB;
constexpr size_t WS_XACC = WS_BIG + 255 * MiB;
constexpr size_t WS_END = WS_XACC + 3 * MiB;
constexpr int SPLIT_ROW0 = 16384;
static_assert(WS_X + (size_t)MP * D * 4 <= WS_XB && WS_XB + (size_t)MP * D * 2 <= WS_MO && WS_MO + (size_t)MP * DFF * 2 <= WS_BIG && WS_MO + (size_t)MP * D * 2 <= WS_FREE, "ws map 1");
static_assert(WS_YR + (size_t)NT * 512 * 2 <= WS_BIG && WS_OD + (size_t)NT * 1024 * 2 <= WS_BIG && WS_GA + (size_t)NT * 256 * 4 <= WS_OG && WS_OG + (size_t)NT * 512 * 2 <= WS_YR, "ws map 2");
static_assert(WS_Z + (size_t)MP * LDZ_AB * 2 <= WS_RPH && WS_RPH + (size_t)NT * 6 * 512 * 2 <= WS_RPW && WS_RPW + (size_t)NT * 512 * 4 <= WS_BON && WS_BON + (size_t)NT * 8 * 4 <= WS_XACC, "ws map 3");
static_assert(WS_Z + (size_t)MP * LDZ_C * 2 <= WS_GQ && WS_GS + (size_t)NT * 32 * 4 <= WS_XACC && WS_Z + (size_t)MP * LDH * 2 <= WS_XACC, "ws map 4");
static_assert(WS_WIN + (size_t)LDZ_C * D * 2 <= WS_WOUT && WS_WOUT + (size_t)D * D * 2 <= WS_WUP && WS_WUP + (size_t)LDH * D * 2 <= WS_WDN && WS_WDN + (size_t)D * DFF * 2 <= WS_X, "ws map 5");

constexpr int LDS_BYTES = 147456;

struct Params { const float* in[39]; float* out; unsigned char* ws; int ph_lo, ph_hi; };

template <int CTRL> DEVINL float dpp_f(float v) { return __builtin_bit_cast(float, __builtin_amdgcn_update_dpp(0, __builtin_bit_cast(int, v), CTRL, 0xf, 0xf, false)); }
DEVINL float red16(float v) { v += dpp_f<0x128>(v); v += dpp_f<0x124>(v); v += dpp_f<0x122>(v); v += dpp_f<0x121>(v); return v; }
DEVINL float wave_sum(float v) {
    v = red16(v);
    v += __builtin_bit_cast(float, __builtin_amdgcn_update_dpp(0, __builtin_bit_cast(int, v), 0x142, 0xa, 0xf, false));
    v += __builtin_bit_cast(float, __builtin_amdgcn_update_dpp(0, __builtin_bit_cast(int, v), 0x143, 0xc, 0xf, false));
    return __builtin_bit_cast(float, __builtin_amdgcn_readlane(__builtin_bit_cast(int, v), 63));
}
DEVINL void bar_sync() { __builtin_amdgcn_fence(__ATOMIC_RELEASE, "workgroup"); __builtin_amdgcn_s_barrier(); __builtin_amdgcn_fence(__ATOMIC_ACQUIRE, "workgroup"); }
DEVINL float sigmoidf_(float x) { return 1.f / (1.f + __expf(-x)); }
DEVINL float siluf_(float x) { return x / (1.f + __expf(-x)); }
DEVINL f32x4 ld_h4(const half_t* p) { const h4 v = *(const h4*)p; return (f32x4){(float)v[0], (float)v[1], (float)v[2], (float)v[3]}; }
DEVINL void st_h4(half_t* p, f32x4 v) { h4 o; o[0] = (half_t)v[0]; o[1] = (half_t)v[1]; o[2] = (half_t)v[2]; o[3] = (half_t)v[3]; *(h4*)p = o; }
DEVINL void ld_h8f(const half_t* p, float (&o)[8]) { const h8 v = *(const h8*)p;
#pragma unroll
    for (int e = 0; e < 8; ++e) o[e] = (float)v[e]; }
DEVINL void ld_f8(const float* p, float (&o)[8]) { const f32x4 a = *(const f32x4*)p, b = *(const f32x4*)(p + 4); o[0] = a[0]; o[1] = a[1]; o[2] = a[2]; o[3] = a[3]; o[4] = b[0]; o[5] = b[1]; o[6] = b[2]; o[7] = b[3]; }
#define LDS_WAIT() asm volatile("s_waitcnt lgkmcnt(0)" ::: "memory")

DEVINL void row_info(int row, int& t, int& sb) { if (row < NTP) { t = row % TP; sb = -1; } else { const int r = row - NTP; t = r & 3; sb = r >> 2; } }

template <int MODE> DEVINL int src_col(int dst, int N) {
    if (MODE == 0) return dst < N ? dst : -1;
    if (dst < 1024) return dst;
    if (dst < 1536) return 1040 + (dst - 1024);
    if (dst < 1552) return 1024 + (dst - 1536);
    if (dst < ZR) return -1;
    return 1552 + (dst - ZR);
}
template <int MODE> DEVINL void convert_w(const float* __restrict__ W, int K, int N, int Npad, half_t* __restrict__ WT, LAS float* scr, int gw, int ngw, int lane) {
    const int nblk = Npad / 32, nitems = (K / 64) * nblk;
    for (int it = gw; it < nitems; it += ngw) {
        const int kb = it / nblk, nb = it - kb * nblk, k0 = 64 * kb, n0 = 32 * nb;
        const int sc = src_col<MODE>(n0 + (lane & 31), N);
#pragma unroll 8
        for (int i = 0; i < 32; ++i) { const int kk = 2 * i + (lane >> 5); scr[kk * 33 + (lane & 31)] = sc >= 0 ? W[(size_t)(k0 + kk) * N + sc] : 0.f; }
        LDS_WAIT();
        const int c = lane & 7;
#pragma unroll
        for (int j = 0; j < 4; ++j) { const int n = (lane >> 3) + 8 * j; const LAS float* s = scr + (8 * c) * 33 + n;
            h8 o;
#pragma unroll
            for (int e = 0; e < 8; ++e) o[e] = (half_t)s[e * 33];
            *(h8*)(WT + (size_t)(n0 + n) * K + k0 + 8 * c) = o; }
        LDS_WAIT();
    }
}
DEVINL void convert_layer_weights(const Params& P, int l, LAS unsigned char* lds, int gw, int ngw, int lane, int wave) {
    LAS float* scr = (LAS float*)(lds + wave * 16384);
    const int i = l >> 1;
    if ((l & 1) == 0) {
        convert_w<1>(P.in[9] + (size_t)i * D * 3344, D, 3344, LDZ_AB, (half_t*)(P.ws + WS_WIN), scr, gw, ngw, lane);
        convert_w<0>(P.in[24] + (size_t)i * D * D, D, D, D, (half_t*)(P.ws + WS_WOUT), scr, gw, ngw, lane);
        {
            half_t* W2T = (half_t*)(P.ws + WS_W2T); half_t* A2T = (half_t*)(P.ws + WS_A2T); half_t* G2T = (half_t*)(P.ws + WS_G2T); half_t* GW2T = (half_t*)(P.ws + WS_GW2T);
            const float* w2 = P.in[15] + (size_t)i * 64 * 512; const float* a2 = P.in[17] + (size_t)i * 64 * 512; const float* g2 = P.in[18] + (size_t)i * 128 * 512; const float* gw2 = P.in[10] + (size_t)i * 16 * 256;
            const int gt = gw * 64 + lane, ngt = ngw * 64;
            for (int idx = gt; idx < 512 * 64; idx += ngt) { const int col = idx >> 6, k = idx & 63; W2T[idx] = (half_t)w2[(size_t)k * 512 + col]; A2T[idx] = (half_t)a2[(size_t)k * 512 + col]; }
            for (int idx = gt; idx < 512 * 128; idx += ngt) { const int col = idx >> 7, k = idx & 127; G2T[idx] = (half_t)g2[(size_t)k * 512 + col]; }
            for (int idx = gt; idx < 256 * 32; idx += ngt) { const int col = idx >> 5, k = idx & 31; GW2T[idx] = k < 16 ? (half_t)gw2[k * 256 + col] : (half_t)0.f; }
        }
    } else {
        convert_w<0>(P.in[25] + (size_t)i * D * 4112, D, 4112, LDZ_C, (half_t*)(P.ws + WS_WIN), scr, gw, ngw, lane);
        convert_w<0>(P.in[30] + (size_t)i * D * D, D, D, D, (half_t*)(P.ws + WS_WOUT), scr, gw, ngw, lane);
    }
    convert_w<0>(P.in[31] + (size_t)l * D * LDH, D, LDH, LDH, (half_t*)(P.ws + WS_WUP), scr, gw, ngw, lane);
    convert_w<0>(P.in[34] + (size_t)l * DFF * D, DFF, D, D, (half_t*)(P.ws + WS_WDN), scr, gw, ngw, lane);
}

DEVINL void zero_xacc(const Params& P, int gw, int ngw, int lane) {
    f32x4* xa = (f32x4*)(P.ws + WS_XACC);
    for (int idx = gw * 64 + lane; idx < 768 * 1024 / 4; idx += ngw * 64) xa[idx] = (f32x4){0.f, 0.f, 0.f, 0.f};
}
DEVINL void phase_prologue(const Params& P, int gw, int ngw, int lane) {
    float* X = (float*)(P.ws + WS_X); half_t* XB = (half_t*)(P.ws + WS_XB);
    for (int row = gw; row < MP; row += ngw) {
        const float* src; float* sh = nullptr;
        if (row < NTP) { const int b = row / TP, t = row - b * TP; src = t < 16 ? P.in[8] + (size_t)t * D : P.in[0] + ((size_t)b * 2048 + (t - 16)) * D; if (t == TP - 1) sh = P.out + O_PSHIFT + (size_t)b * D; }
        else if (row < NT) { const int r = row - NTP; src = P.in[1] + (size_t)r * D; if ((r & 3) == 3) sh = P.out + O_SSHIFT + (size_t)(r >> 2) * D; }
        else if (row < NT + NBS) src = P.in[4] + (size_t)(row - NT) * D;
        else src = nullptr;
#pragma unroll
        for (int j = 0; j < 4; ++j) {
            const f32x4 v = src ? ((const f32x4*)src)[lane + 64 * j] : (f32x4){0.f, 0.f, 0.f, 0.f};
            if (row < NT) ((f32x4*)(X + (size_t)row * D))[lane + 64 * j] = v;
            st_h4(XB + (size_t)row * D + 4 * (lane + 64 * j), v);
            if (sh) ((f32x4*)sh)[lane + 64 * j] = v;
        }
    }
}

DEVINL void phase_ln(const Params& P, const float* __restrict__ g, const float* __restrict__ bta, bool final, int shift_i, int gw, int ngw, int lane, bool dummy = false) {
    float* X = (float*)(P.ws + WS_X); half_t* XB = (half_t*)(P.ws + WS_XB);
    float* XO = dummy ? (float*)(P.ws + WS_Z) : X; half_t* XBO = dummy ? (half_t*)(P.ws + WS_Z + 80 * MiB) : XB;
    f32x4 gv[4], bv[4];
#pragma unroll
    for (int j = 0; j < 4; ++j) { gv[j] = ((const f32x4*)g)[lane + 64 * j]; bv[j] = ((const f32x4*)bta)[lane + 64 * j]; }
    for (int row = gw; row < NT; row += ngw) {
        f32x4* xr = (f32x4*)(X + (size_t)row * D);
        f32x4 v[4]; float s = 0.f;
#pragma unroll
        for (int j = 0; j < 4; ++j) { v[j] = xr[lane + 64 * j]; if (row >= SPLIT_ROW0) v[j] = v[j] * ALPHA + ((const f32x4*)(P.ws + WS_XACC + (size_t)(row - SPLIT_ROW0) * D * 4))[lane + 64 * j]; s += (v[j][0] + v[j][1]) + (v[j][2] + v[j][3]); }
        const float mean = wave_sum(s) * (1.f / D); float s2 = 0.f;
#pragma unroll
        for (int j = 0; j < 4; ++j) { v[j] = v[j] - mean; s2 += (v[j][0] * v[j][0] + v[j][1] * v[j][1]) + (v[j][2] * v[j][2] + v[j][3] * v[j][3]); }
        const float rstd = rsqrtf(wave_sum(s2) * (1.f / D) + 1e-5f);
        int t, sb; row_info(row, t, sb);
        float* dst = nullptr; float* sh = nullptr;
        if (final) { if (sb >= 0) dst = P.out + O_YS + (size_t)(row - NTP) * D; else if (t >= 16) dst = P.out + O_YP + ((size_t)(row / TP) * 2048 + (t - 16)) * D; }
        if (shift_i >= 0) { if (sb >= 0) { if (t == 3) sh = P.out + O_SSHIFT + ((size_t)shift_i * NBS + sb) * D; } else if (t == TP - 1) sh = P.out + O_PSHIFT + ((size_t)shift_i * NBP + row / TP) * D; }
#pragma unroll
        for (int j = 0; j < 4; ++j) {
            const f32x4 y = v[j] * rstd * gv[j] + bv[j];
            if (final) { if (dst) ((f32x4*)dst)[lane + 64 * j] = y; }
            else { ((f32x4*)(XO + (size_t)row * D))[lane + 64 * j] = y; st_h4(XBO + (size_t)row * D + 4 * (lane + 64 * j), y); }
            if (sh) ((f32x4*)sh)[lane + 64 * j] = y;
        }
    }
    if (shift_i >= 0) {
        const float* st = P.in[4] + (size_t)shift_i * NBS * D;
        for (int b = gw; b < NBS; b += ngw)
#pragma unroll
            for (int j = 0; j < 4; ++j) st_h4(XB + (size_t)(NT + b) * D + 4 * (lane + 64 * j), ((const f32x4*)(st + (size_t)b * D))[lane + 64 * j]);
    }
}

DEVINL void phase_act(const Params& P, int l, int gw, int ngw, int lane) {
    const half_t* H = (const half_t*)(P.ws + WS_Z); half_t* A2 = (half_t*)(P.ws + WS_MO);
    const float* cw = P.in[32] + (size_t)l * 3 * DFF; const float* cb = P.in[33] + (size_t)l * DFF; const float* st = P.in[7] + (size_t)l * NBS * 2 * DFF;
    constexpr int NCG = 6, NRB = NT / 16;
    for (int it = gw; it < NRB * NCG; it += ngw) {
        const int rb = it / NCG, cgp = it - rb * NCG, c = cgp * 512 + lane * 8, r0 = rb * 16;
        if (c >= DFF) continue;
        float w0[8], w1[8], w2[8], bb[8], g1[8], g2[8];
        ld_f8(cw + c, w0); ld_f8(cw + DFF + c, w1); ld_f8(cw + 2 * DFF + c, w2); ld_f8(cb + c, bb);
        const bool prompt = r0 < NTP;
        if (prompt) {
            const int t0 = r0 % TP;
            if (t0 == 0) {
#pragma unroll
                for (int e = 0; e < 8; ++e) { g1[e] = 0.f; g2[e] = 0.f; } }
            else { ld_h8f(H + (size_t)(r0 - 1) * LDH + c, g1); ld_h8f(H + (size_t)(r0 - 2) * LDH + c, g2); }
        }
#pragma unroll 4
        for (int i = 0; i < 16; ++i) {
            const int row = r0 + i;
            if (!prompt && (i & 3) == 0) { const int sb = (row - NTP) >> 2; ld_f8(st + ((size_t)sb * 2 + 1) * DFF + c, g1); ld_f8(st + (size_t)sb * 2 * DFF + c, g2); }
            float g0[8], up[8]; ld_h8f(H + (size_t)row * LDH + c, g0); ld_h8f(H + (size_t)row * LDH + DFF + c, up);
            h8 o;
#pragma unroll
            for (int e = 0; e < 8; ++e) { const float x = w2[e] * g0[e] + w1[e] * g1[e] + w0[e] * g2[e] + bb[e]; o[e] = (half_t)(siluf_(x) * up[e]); g2[e] = g1[e]; g1[e] = g0[e]; }
            *(h8*)(A2 + (size_t)row * DFF + c) = o;
        }
    }
    for (int q = gw; q < NSEQ * 2; q += ngw) {
        const int s = q >> 1, j = q & 1;
        const int row = s < NBP ? s * TP + TP - 2 + j : NTP + (s - NBP) * 4 + 2 + j;
        float* dst = s < NBP ? P.out + O_PFFNCONV + (((size_t)l * NBP + s) * 2 + j) * DFF : P.out + O_SFFNCONV + (((size_t)l * NBS + (s - NBP)) * 2 + j) * DFF;
        for (int p = 0; p < 11; ++p) { const int c = p * 256 + lane * 4; *(f32x4*)(dst + c) = ld_h4(H + (size_t)row * LDH + c); }
    }
}

DEVINL const half_t* zprev_row(const half_t* Z, int row, int ldz) {
    if (row < NTP) return (row % TP) == 0 ? nullptr : Z + (size_t)(row - 1) * ldz;
    const int r = row - NTP; return (r & 3) == 0 ? Z + (size_t)(NT + (r >> 2)) * ldz : Z + (size_t)(row - 1) * ldz;
}
DEVINL void phase_prep_ab(const Params& P, int i, LAS unsigned char* lds, int tid, int lane, int wave, int G) {
    const half_t* Z = (const half_t*)(P.ws + WS_Z);
    half_t* RPH = (half_t*)(P.ws + WS_RPH); float* RPW = (float*)(P.ws + WS_RPW); float* BON = (float*)(P.ws + WS_BON); float* GA = (float*)(P.ws + WS_GA);
    const half_t* W2T = (const half_t*)(P.ws + WS_W2T); const half_t* A2T = (const half_t*)(P.ws + WS_A2T); const half_t* G2T = (const half_t*)(P.ws + WS_G2T); const half_t* GW2T = (const half_t*)(P.ws + WS_GW2T);
    const float* mu = P.in[13] + (size_t)i * 1792; const float* w0 = P.in[14] + i * 512; const float* a0 = P.in[16] + i * 512;
    const float* k_k = P.in[19] + i * 512; const float* k_a = P.in[20] + i * 512; const float* r_k = P.in[21] + i * 512; const float* gb = P.in[11] + i * 256;
    constexpr int XS = 264, GS_ = 40;
    LAS half_t* XL = (LAS half_t*)lds;
    LAS half_t* XG = XL + 16 * XS;
    const int tok0 = lane & 15, cg0 = lane >> 4, h = wave;
    for (int tile = blockIdx.x; tile < NT / 16; tile += G) {
        const int r0 = tile * 16;
        int tok = tok0, cg = cg0; asm volatile("" : "+v"(tok), "+v"(cg));
        {
            const int t2 = tid >> 5, c8 = (tid & 31) * 8, row = r0 + t2;
            const half_t* zc = Z + (size_t)row * LDZ_AB + ZR + 1536 + c8; const half_t* zp = zprev_row(Z, row, LDZ_AB);
            float cur[8], prv[8], m[8]; ld_h8f(zc, cur); ld_f8(mu + 1536 + c8, m);
            if (zp) ld_h8f(zp + ZR + 1536 + c8, prv); else {
#pragma unroll
                for (int e = 0; e < 8; ++e) prv[e] = 0.f; }
            h8 o;
#pragma unroll
            for (int e = 0; e < 8; ++e) { float v = cur[e] + m[e] * (prv[e] - cur[e]); if (c8 < 64) v = tanhf(v); else if (c8 >= 128) v = sigmoidf_(v); o[e] = (half_t)v; }
            *(LAS h8*)(XL + t2 * XS + c8) = o;
            if (tid < 64) { const int t3 = tid >> 2, q = tid & 3; h8 gq = {};
                if (q < 2) gq = *(const h8*)(Z + (size_t)(r0 + t3) * LDZ_AB + 1536 + q * 8);
                *(LAS h8*)(XG + t3 * GS_ + q * 8) = gq; }
        }
        bar_sync();
        {   const int row = r0 + tok;
            const half_t* zc = Z + (size_t)row * LDZ_AB + ZR; const half_t* zp = zprev_row(Z, row, LDZ_AB);
            half_t* rp = RPH + (size_t)row * 3072;
            float ss = 0.f, bon = 0.f; f32x4 kkr[4], alr[4];
            h8 bx[8];
#pragma unroll
            for (int s = 0; s < 8; ++s) bx[s] = *(const LAS h8*)(XL + tok * XS + s * 32 + 8 * cg);
#pragma unroll
            for (int f = 0; f < 4; ++f) {
                f32x4 aw = {0.f, 0.f, 0.f, 0.f}, aa = aw, ag = aw;
                const int wc = h * 64 + f * 16 + tok;
#pragma unroll
                for (int s = 0; s < 2; ++s) { const h8 wa = *(const h8*)(W2T + (size_t)wc * 64 + s * 32 + 8 * cg); aw = __builtin_amdgcn_mfma_f32_16x16x32_f16(wa, bx[s], aw, 0, 0, 0); }
#pragma unroll
                for (int s = 0; s < 2; ++s) { const h8 wa = *(const h8*)(A2T + (size_t)wc * 64 + s * 32 + 8 * cg); aa = __builtin_amdgcn_mfma_f32_16x16x32_f16(wa, bx[2 + s], aa, 0, 0, 0); }
#pragma unroll
                for (int s = 0; s < 4; ++s) { const h8 wa = *(const h8*)(G2T + (size_t)wc * 128 + s * 32 + 8 * cg); ag = __builtin_amdgcn_mfma_f32_16x16x32_f16(wa, bx[4 + s], ag, 0, 0, 0); }
                const int c = h * 64 + f * 16 + cg * 4;
                f32x4 pr = {0.f, 0.f, 0.f, 0.f}, pk = pr, pv = pr;
                const f32x4 cr = ld_h4(zc + c), ck = ld_h4(zc + 512 + c), cv = ld_h4(zc + 1024 + c);
                if (zp) { pr = ld_h4(zp + ZR + c); pk = ld_h4(zp + ZR + 512 + c); pv = ld_h4(zp + ZR + 1024 + c); }
                const f32x4 r = cr + *(const f32x4*)(mu + c) * (pr - cr), kr = ck + *(const f32x4*)(mu + 512 + c) * (pk - ck), vr = cv + *(const f32x4*)(mu + 1024 + c) * (pv - cv);
                const f32x4 wr = aw + *(const f32x4*)(w0 + c), ar = aa + *(const f32x4*)(a0 + c);
                f32x4 dec, al;
#pragma unroll
                for (int e = 0; e < 4; ++e) { dec[e] = __expf(-0.6065306597126334f * sigmoidf_(wr[e])); al[e] = sigmoidf_(ar[e]); }
                const f32x4 kk0 = kr * *(const f32x4*)(k_k + c);
                const f32x4 kmod = kr * ((al - 1.f) * *(const f32x4*)(k_a + c) + 1.f);
                const f32x4 bt = r * kmod * *(const f32x4*)(r_k + c);
                ss += (kk0[0] * kk0[0] + kk0[1] * kk0[1]) + (kk0[2] * kk0[2] + kk0[3] * kk0[3]); bon += (bt[0] + bt[1]) + (bt[2] + bt[3]);
                kkr[f] = kk0; alr[f] = al;
                st_h4(rp + c, r); st_h4(rp + 512 + c, kmod); st_h4(rp + 1024 + c, vr); st_h4(rp + 2560 + c, ag);
                *(f32x4*)(RPW + (size_t)row * 512 + c) = dec;
                asm volatile("" ::: "memory");
            }
            ss += __shfl_xor(ss, 16); ss += __shfl_xor(ss, 32); bon += __shfl_xor(bon, 16); bon += __shfl_xor(bon, 32);
            const float inv = rsqrtf(ss + 1e-6f);
#pragma unroll
            for (int f = 0; f < 4; ++f) { const int c = h * 64 + f * 16 + cg * 4; const f32x4 kk = kkr[f] * inv; st_h4(rp + 1536 + c, kk); st_h4(rp + 2048 + c, kk * alr[f]); }
            if (cg == 0) BON[(size_t)row * 8 + h] = bon;
            const h8 bg = *(const LAS h8*)(XG + tok * GS_ + 8 * cg);
#pragma unroll
            for (int q = 0; q < 2; ++q) {
                const int nf = wave * 2 + q;
                const h8 wa = *(const h8*)(GW2T + (size_t)(nf * 16 + tok) * 32 + 8 * cg);
                f32x4 x = __builtin_amdgcn_mfma_f32_16x16x32_f16(wa, bg, (f32x4){0.f, 0.f, 0.f, 0.f}, 0, 0, 0);
                const int c = nf * 16 + cg * 4; x = x + *(const f32x4*)(gb + c);
                f32x4 a;
#pragma unroll
                for (int e = 0; e < 4; ++e) { const float ls = fminf(x[e], 0.f) - log1pf(__expf(-fabsf(x[e]))); a[e] = __expf(ls * 0.0625f); }
                *(f32x4*)(GA + (size_t)row * 256 + c) = a;
            }
        }
        bar_sync();
    }
}

struct GlaS { float S[4]; f32x4 a[4]; h4 k[4], q[4]; half_t v[4]; };
DEVINL void gla_s_load(const Params& P, int i, int x, int lane, int wave, GlaS& r) {
    const half_t* Z = (const half_t*)(P.ws + WS_Z); const float* GA = (const float*)(P.ws + WS_GA);
    const int sb = x >> 4, h = (x >> 2) & 3, g = x & 3, col = g * 32 + wave * 4 + (lane >> 4), ks = lane & 15, row0 = NTP + sb * 4;
    const float* s0 = P.in[2] + (((size_t)i * NBS + sb) * 4 + h) * 8192;
#pragma unroll
    for (int e = 0; e < 4; ++e) r.S[e] = s0[(size_t)(ks * 4 + e) * 128 + col];
    const half_t* zq = Z + (size_t)row0 * LDZ_AB + h * 64 + ks * 4;
#pragma unroll
    for (int u = 0; u < 4; ++u) { r.a[u] = *(const f32x4*)(GA + (size_t)(row0 + u) * 256 + h * 64 + ks * 4); r.q[u] = *(const h4*)(zq + (size_t)u * LDZ_AB); r.k[u] = *(const h4*)(zq + (size_t)u * LDZ_AB + 256);
        r.v[u] = Z[(size_t)(row0 + u) * LDZ_AB + 512 + h * 128 + col]; }
}
DEVINL void gla_s_run(const Params& P, int i, int x, int lane, int wave, GlaS& r) {
    half_t* OG = (half_t*)(P.ws + WS_OG);
    const int sb = x >> 4, h = (x >> 2) & 3, g = x & 3, col = g * 32 + wave * 4 + (lane >> 4), ks = lane & 15, row0 = NTP + sb * 4;
    float* sout = P.out + O_SGLA + (((size_t)i * NBS + sb) * 4 + h) * 8192;
#pragma unroll
    for (int u = 0; u < 4; ++u) {
        const float v = (float)r.v[u]; float o = 0.f;
#pragma unroll
        for (int e = 0; e < 4; ++e) { r.S[e] = r.S[e] * r.a[u][e] + (float)r.k[u][e] * v; o += r.S[e] * (float)r.q[u][e]; }
        o = red16(o);
        if (ks == 0) OG[(size_t)(row0 + u) * 512 + h * 128 + col] = (half_t)(o * 0.125f);
    }
#pragma unroll
    for (int e = 0; e < 4; ++e) sout[(size_t)(ks * 4 + e) * 128 + col] = r.S[e];
}
struct RwS { float S[4]; f32x4 w[4]; h4 r[4], k[4], kk[4], b[4]; half_t v[4]; };
DEVINL void rw_s_load(const Params& P, int i, int x, int lane, int wave, RwS& r) {
    const half_t* RPH = (const half_t*)(P.ws + WS_RPH); const float* RPW = (const float*)(P.ws + WS_RPW);
    const int sb = x >> 4, h = (x >> 1) & 7, rg = x & 1, rv = rg * 32 + wave * 4 + (lane >> 4), ks = lane & 15, row0 = NTP + sb * 4;
    const float* s0 = P.in[3] + (((size_t)i * NBS + sb) * 8 + h) * 4096;
    const f32x4 sv = *(const f32x4*)(s0 + (size_t)rv * 64 + ks * 4);
    r.S[0] = sv[0]; r.S[1] = sv[1]; r.S[2] = sv[2]; r.S[3] = sv[3];
#pragma unroll
    for (int u = 0; u < 4; ++u) { const half_t* rp = RPH + (size_t)(row0 + u) * 3072 + h * 64 + ks * 4;
        r.w[u] = *(const f32x4*)(RPW + (size_t)(row0 + u) * 512 + h * 64 + ks * 4); r.r[u] = *(const h4*)rp; r.k[u] = *(const h4*)(rp + 512); r.kk[u] = *(const h4*)(rp + 1536); r.b[u] = *(const h4*)(rp + 2048);
        r.v[u] = RPH[(size_t)(row0 + u) * 3072 + 1024 + h * 64 + rv]; }
}
DEVINL void rw_s_run(const Params& P, int i, int x, int lane, int wave, RwS& r) {
    half_t* YR = (half_t*)(P.ws + WS_YR);
    const int sb = x >> 4, h = (x >> 1) & 7, rg = x & 1, rv = rg * 32 + wave * 4 + (lane >> 4), ks = lane & 15, row0 = NTP + sb * 4;
    float* sout = P.out + O_SRWKV + (((size_t)i * NBS + sb) * 8 + h) * 4096;
#pragma unroll
    for (int u = 0; u < 4; ++u) {
        float sa = 0.f;
#pragma unroll
        for (int e = 0; e < 4; ++e) sa -= r.S[e] * (float)r.kk[u][e];
        sa = red16(sa);
        const float v = (float)r.v[u]; float y = 0.f;
#pragma unroll
        for (int e = 0; e < 4; ++e) { r.S[e] = r.S[e] * r.w[u][e] + sa * (float)r.b[u][e] + v * (float)r.k[u][e]; y += r.S[e] * (float)r.r[u][e]; }
        y = red16(y);
        if (ks == 0) YR[(size_t)(row0 + u) * 512 + h * 64 + rv] = (half_t)y;
    }
    *(f32x4*)(sout + (size_t)rv * 64 + ks * 4) = (f32x4){r.S[0], r.S[1], r.S[2], r.S[3]};
}

constexpr int SC = 32;
DEVINL void gla_item_lds(const Params& P, LAS unsigned char* lds, int row0, int T, int h, int g, float* sout, int tid, int lane, int wave) {
    constexpr int TOKB = 576, BUFB = SC * TOKB, OB = 2 * BUFB, OBB = SC * 32 * 2 + 1024;
    const half_t* Z = (const half_t*)(P.ws + WS_Z); const float* GA = (const float*)(P.ws + WS_GA); half_t* OG = (half_t*)(P.ws + WS_OG);
    const int cl = wave * 4 + (lane >> 4), col = g * 32 + cl, ks = lane & 15;
    float S[4] = {0.f, 0.f, 0.f, 0.f}; const int dmy = SC * 32 + tid;
    const int a_tok = tid >> 4, a_c4 = (tid & 15) * 4, kq_sel = tid >> 8, kq_tok = (tid & 255) >> 3, kq_c8 = (tid & 7) * 8, v_tok = (tid & 127) >> 2, v_c8 = (tid & 3) * 8;
    const float* ga = GA + (size_t)(row0 + a_tok) * 256 + h * 64 + a_c4;
    const half_t* zkq = Z + (size_t)(row0 + kq_tok) * LDZ_AB + (kq_sel ? 0 : 256) + h * 64 + kq_c8;
    const half_t* zv = Z + (size_t)(row0 + v_tok) * LDZ_AB + 512 + h * 128 + g * 32 + v_c8;
    const int a_off = a_tok * TOKB + a_c4 * 4, kq_off = kq_tok * TOKB + 256 + kq_sel * 128 + kq_c8 * 2, v_off = v_tok * TOKB + 512 + v_c8 * 2;
    f32x4 ra = {0.f, 0.f, 0.f, 0.f}; h8 rkq = {}, rv = {};
#define GLA_LOAD(t0) do { if ((t0) + a_tok < T) ra = *(const f32x4*)(ga + (size_t)(t0) * 256); if ((t0) + kq_tok < T) rkq = *(const h8*)(zkq + (size_t)(t0) * LDZ_AB); \
        if (tid < 128 && (t0) + v_tok < T) rv = *(const h8*)(zv + (size_t)(t0) * LDZ_AB); } while (0)
#define GLA_STORE(bi) do { LAS unsigned char* b_ = lds + (bi) * BUFB; *(LAS f32x4*)(b_ + a_off) = ra; *(LAS h8*)(b_ + kq_off) = rkq; if (tid < 128) *(LAS h8*)(b_ + v_off) = rv; } while (0)
    GLA_LOAD(0); GLA_STORE(0); bar_sync();
    int c = 0;
    for (int t0 = 0; t0 < T; t0 += SC, ++c) {
        const bool more = t0 + SC < T; if (more) GLA_LOAD(t0 + SC);
        const int n = (T - t0) < SC ? (T - t0) : SC;
        const LAS unsigned char* base = lds + (c & 1) * BUFB; LAS half_t* ob = (LAS half_t*)(lds + OB + (c & 1) * OBB);
#define GLA_OP(A, K, Q, V, tt) do { const LAS unsigned char* tb_ = base + (tt) * TOKB; A = *(const LAS f32x4*)(tb_ + ks * 16); K = *(const LAS h4*)(tb_ + 256 + ks * 8); Q = *(const LAS h4*)(tb_ + 384 + ks * 8); V = *(const LAS half_t*)(tb_ + 512 + cl * 2); } while (0)
#define GLA_STEP(A, K, Q, V, tt) do { const float v_ = (float)V; float o_ = 0.f; _Pragma("unroll") for (int e = 0; e < 4; ++e) { S[e] = S[e] * A[e] + (float)K[e] * v_; o_ += S[e] * (float)Q[e]; } \
        o_ = red16(o_); ob[ks == 0 ? (tt) * 32 + cl : dmy] = (half_t)(o_ * 0.125f); } while (0)
        {   f32x4 a0, a1; h4 k0, k1, q0, q1; half_t v0, v1;
            GLA_OP(a0, k0, q0, v0, 0);
            for (int t = 0; t < n; t += 2) { GLA_OP(a1, k1, q1, v1, t + 1); GLA_STEP(a0, k0, q0, v0, t); GLA_OP(a0, k0, q0, v0, t + 2); GLA_STEP(a1, k1, q1, v1, t + 1); }
        }
#undef GLA_OP
#undef GLA_STEP
        if (more) GLA_STORE((c + 1) & 1);
        bar_sync();
        if (tid < 128 && v_tok < n) *(h8*)(OG + (size_t)(row0 + t0 + v_tok) * 512 + h * 128 + g * 32 + v_c8) = *(const LAS h8*)(ob + v_tok * 32 + v_c8);
    }
#undef GLA_LOAD
#undef GLA_STORE
#pragma unroll
    for (int e = 0; e < 4; ++e) sout[(size_t)(ks * 4 + e) * 128 + col] = S[e];
    bar_sync();
}
DEVINL void rwkv_item_lds(const Params& P, LAS unsigned char* lds, int row0, int T, int h, int rg, float* sout, int tid, int lane, int wave) {
    constexpr int TOKB = 832, BUFB = SC * TOKB, OB = 2 * BUFB, OBB = SC * 32 * 2 + 1024;
    const half_t* RPH = (const half_t*)(P.ws + WS_RPH); const float* RPW = (const float*)(P.ws + WS_RPW); half_t* YR = (half_t*)(P.ws + WS_YR);
    const int rl = wave * 4 + (lane >> 4), rv_ = rg * 32 + rl, ks = lane & 15;
    float S[4] = {0.f, 0.f, 0.f, 0.f}; const int dmy = SC * 32 + tid;
    const int w_tok = tid >> 4, w_c4 = (tid & 15) * 4, x_sel = tid >> 8, x_tok = (tid & 255) >> 3, x_c8 = (tid & 7) * 8, v_tok = (tid & 127) >> 2, v_c8 = (tid & 3) * 8;
    const float* wp = RPW + (size_t)(row0 + w_tok) * 512 + h * 64 + w_c4;
    const half_t* xp0 = RPH + (size_t)(row0 + x_tok) * 3072 + (x_sel ? 1536 : 0) + h * 64 + x_c8;
    const half_t* xp1 = RPH + (size_t)(row0 + x_tok) * 3072 + (x_sel ? 2048 : 512) + h * 64 + x_c8;
    const half_t* vp = RPH + (size_t)(row0 + v_tok) * 3072 + 1024 + h * 64 + rg * 32 + v_c8;
    const int w_off = w_tok * TOKB + w_c4 * 4, x_off0 = x_tok * TOKB + 256 + (x_sel ? 256 : 0) + x_c8 * 2, x_off1 = x_off0 + 128, v_off = v_tok * TOKB + 768 + v_c8 * 2;
    f32x4 rw = {0.f, 0.f, 0.f, 0.f}; h8 rx0 = {}, rx1 = {}, rvv = {};
#define RW_LOAD(t0) do { if ((t0) + w_tok < T) rw = *(const f32x4*)(wp + (size_t)(t0) * 512); if ((t0) + x_tok < T) { rx0 = *(const h8*)(xp0 + (size_t)(t0) * 3072); rx1 = *(const h8*)(xp1 + (size_t)(t0) * 3072); } \
        if (tid < 128 && (t0) + v_tok < T) rvv = *(const h8*)(vp + (size_t)(t0) * 3072); } while (0)
#define RW_STORE(bi) do { LAS unsigned char* b_ = lds + (bi) * BUFB; *(LAS f32x4*)(b_ + w_off) = rw; *(LAS h8*)(b_ + x_off0) = rx0; *(LAS h8*)(b_ + x_off1) = rx1; if (tid < 128) *(LAS h8*)(b_ + v_off) = rvv; } while (0)
    RW_LOAD(0); RW_STORE(0); bar_sync();
    int c = 0;
    for (int t0 = 0; t0 < T; t0 += SC, ++c) {
        const bool more = t0 + SC < T; if (more) RW_LOAD(t0 + SC);
        const int n = (T - t0) < SC ? (T - t0) : SC;
        const LAS unsigned char* base = lds + (c & 1) * BUFB; LAS half_t* ob = (LAS half_t*)(lds + OB + (c & 1) * OBB);
#define RW_OP(W, R, K, KK, B, V, tt) do { const LAS unsigned char* tb_ = base + (tt) * TOKB; W = *(const LAS f32x4*)(tb_ + ks * 16); R = *(const LAS h4*)(tb_ + 256 + ks * 8); K = *(const LAS h4*)(tb_ + 384 + ks * 8); \
        KK = *(const LAS h4*)(tb_ + 512 + ks * 8); B = *(const LAS h4*)(tb_ + 640 + ks * 8); V = *(const LAS half_t*)(tb_ + 768 + rl * 2); } while (0)
#define RW_STEP(W, R, K, KK, B, V, tt) do { float sa_ = 0.f; _Pragma("unroll") for (int e = 0; e < 4; ++e) sa_ -= S[e] * (float)KK[e]; sa_ = red16(sa_); const float v_ = (float)V; float y_ = 0.f; \
        _Pragma("unroll") for (int e = 0; e < 4; ++e) { S[e] = S[e] * W[e] + sa_ * (float)B[e] + v_ * (float)K[e]; y_ += S[e] * (float)R[e]; } \
        y_ = red16(y_); ob[ks == 0 ? (tt) * 32 + rl : dmy] = (half_t)y_; } while (0)
        {   f32x4 w0, w1; h4 r0, r1, k0, k1, kk0, kk1, b0, b1; half_t v0, v1;
            RW_OP(w0, r0, k0, kk0, b0, v0, 0);
            for (int t = 0; t < n; t += 2) { RW_OP(w1, r1, k1, kk1, b1, v1, t + 1); RW_STEP(w0, r0, k0, kk0, b0, v0, t); RW_OP(w0, r0, k0, kk0, b0, v0, t + 2); RW_STEP(w1, r1, k1, kk1, b1, v1, t + 1); }
        }
#undef RW_OP
#undef RW_STEP
        if (more) RW_STORE((c + 1) & 1);
        bar_sync();
        if (tid < 128 && v_tok < n) *(h8*)(YR + (size_t)(row0 + t0 + v_tok) * 512 + h * 64 + rg * 32 + v_c8) = *(const LAS h8*)(ob + v_tok * 32 + v_c8);
    }
#undef RW_LOAD
#undef RW_STORE
#pragma unroll
    for (int e = 0; e < 4; ++e) sout[(size_t)rv_ * 64 + ks * 4 + e] = S[e];
    bar_sync();
}
DEVINL void gdn_item_lds(const Params& P, LAS unsigned char* lds, int row0, int T, int h, int g, float* sout, int tid, int lane, int wave) {
    constexpr int TOKF = 292, BUFF = SC * TOKF, OB = 2 * BUFF * 4, OBB = SC * 32 * 2 + 1024;
    const half_t* GQ = (const half_t*)(P.ws + WS_GQ); const half_t* GK = (const half_t*)(P.ws + WS_GK); const half_t* GV = (const half_t*)(P.ws + WS_GV); const float* GS = (const float*)(P.ws + WS_GS);
    half_t* OD = (half_t*)(P.ws + WS_OD);
    LAS float* lf = (LAS float*)lds;
    const int cl = wave * 4 + (lane >> 4), col = g * 32 + cl, ks = lane & 15;
    f32x2 S2[4]; const int dmy = SC * 32 + tid;
#pragma unroll
    for (int e = 0; e < 4; ++e) S2[e] = (f32x2){0.f, 0.f};
    const int s_tok = tid >> 4, s_ks = tid & 15, v_tok = (tid & 127) >> 2, v_c8 = (tid & 3) * 8, c_tok = (tid - 128) & 31;
    const half_t* kp = GK + (size_t)(row0 + s_tok) * 1024 + h * 128 + s_ks * 8; const half_t* qp = GQ + (size_t)(row0 + s_tok) * 1024 + h * 128 + s_ks * 8;
    const half_t* vp = GV + (size_t)(row0 + v_tok) * 1024 + h * 128 + g * 32 + v_c8;
    const float* sp = GS + ((size_t)(row0 + c_tok) * 8 + h) * 4;
    const bool is_v = tid < 128, is_c = tid >= 128 && tid < 160;
    h8 rk = {}, rq = {}, rv = {}; f32x4 rs = {0.f, 0.f, 0.f, 0.f};
#define GD_LOAD(t0) do { if ((t0) + s_tok < T) { rk = *(const h8*)(kp + (size_t)(t0) * 1024); rq = *(const h8*)(qp + (size_t)(t0) * 1024); } \
        if (is_v && (t0) + v_tok < T) rv = *(const h8*)(vp + (size_t)(t0) * 1024); if (is_c && (t0) + c_tok < T) rs = *(const f32x4*)(sp + (size_t)(t0) * 32); } while (0)
#define GD_STORE(bi) do { LAS float* b_ = lf + (bi) * BUFF; LAS float* tk = b_ + s_tok * TOKF + s_ks * 4; \
        *(LAS f32x4*)(tk) = (f32x4){(float)rk[0], (float)rk[1], (float)rk[2], (float)rk[3]}; *(LAS f32x4*)(tk + 64) = (f32x4){(float)rk[4], (float)rk[5], (float)rk[6], (float)rk[7]}; \
        *(LAS f32x4*)(tk + 128) = (f32x4){(float)rq[0], (float)rq[1], (float)rq[2], (float)rq[3]}; *(LAS f32x4*)(tk + 192) = (f32x4){(float)rq[4], (float)rq[5], (float)rq[6], (float)rq[7]}; \
        if (is_v) { LAS float* tv = b_ + v_tok * TOKF + 256 + v_c8; *(LAS f32x4*)(tv) = (f32x4){(float)rv[0], (float)rv[1], (float)rv[2], (float)rv[3]}; *(LAS f32x4*)(tv + 4) = (f32x4){(float)rv[4], (float)rv[5], (float)rv[6], (float)rv[7]}; } \
        if (is_c) *(LAS f32x4*)(b_ + c_tok * TOKF + 288) = rs; } while (0)
    GD_LOAD(0); GD_STORE(0); bar_sync();
    int c = 0;
    for (int t0 = 0; t0 < T; t0 += SC, ++c) {
        const bool more = t0 + SC < T; if (more) GD_LOAD(t0 + SC);
        const int n = (T - t0) < SC ? (T - t0) : SC;
        const LAS float* base = lf + (c & 1) * BUFF; LAS half_t* ob = (LAS half_t*)(lds + OB + (c & 1) * OBB);
#define GD_OP(K0, K1, Q0, Q1, V, SCL, tt) do { const LAS float* tb_ = base + (tt) * TOKF; K0 = *(const LAS f32x4*)(tb_ + ks * 4); K1 = *(const LAS f32x4*)(tb_ + 64 + ks * 4); Q0 = *(const LAS f32x4*)(tb_ + 128 + ks * 4); \
        Q1 = *(const LAS f32x4*)(tb_ + 192 + ks * 4); V = tb_[256 + cl]; SCL = *(const LAS f32x4*)(tb_ + 288); } while (0)
#define GD_STEP(K0, K1, Q0, Q1, V, SCL, tt) do { const f32x2 ka = {K0[0], K0[1]}, kb = {K0[2], K0[3]}, kc = {K1[0], K1[1]}, kd = {K1[2], K1[3]}; \
        const f32x2 qa = {Q0[0], Q0[1]}, qb = {Q0[2], Q0[3]}, qc = {Q1[0], Q1[1]}, qd = {Q1[2], Q1[3]}; \
        f32x2 p1 = S2[0] * ka; p1 = S2[1] * kb + p1; p1 = S2[2] * kc + p1; p1 = S2[3] * kd + p1; \
        f32x2 p2 = S2[0] * qa; p2 = S2[1] * qb + p2; p2 = S2[2] * qc + p2; p2 = S2[3] * qd + p2; \
        const float d1 = red16(p1[0] + p1[1]), d2 = red16(p2[0] + p2[1]); \
        const float beta = SCL[0], eg = SCL[1], qk = SCL[2]; const float uu = beta * (V - eg * d1); const f32x2 eg2 = {eg, eg}, uu2 = {uu, uu}; \
        S2[0] = S2[0] * eg2 + ka * uu2; S2[1] = S2[1] * eg2 + kb * uu2; S2[2] = S2[2] * eg2 + kc * uu2; S2[3] = S2[3] * eg2 + kd * uu2; \
        ob[ks == 0 ? (tt) * 32 + cl : dmy] = (half_t)(eg * d2 + qk * uu); } while (0)
        {   f32x4 ka0, kb0, qa0, qb0, sc0, ka1, kb1, qa1, qb1, sc1; float v0, v1;
            GD_OP(ka0, kb0, qa0, qb0, v0, sc0, 0);
            for (int t = 0; t < n; t += 2) { GD_OP(ka1, kb1, qa1, qb1, v1, sc1, t + 1); GD_STEP(ka0, kb0, qa0, qb0, v0, sc0, t); GD_OP(ka0, kb0, qa0, qb0, v0, sc0, t + 2); GD_STEP(ka1, kb1, qa1, qb1, v1, sc1, t + 1); }
        }
#undef GD_OP
#undef GD_STEP
        if (more) GD_STORE((c + 1) & 1);
        bar_sync();
        if (is_v && v_tok < n) *(h8*)(OD + (size_t)(row0 + t0 + v_tok) * 1024 + h * 128 + g * 32 + v_c8) = *(const LAS h8*)(ob + v_tok * 32 + v_c8);
    }
#undef GD_LOAD
#undef GD_STORE
#pragma unroll
    for (int e = 0; e < 4; ++e) { sout[(size_t)(ks * 8 + 2 * e) * 128 + col] = S2[e][0]; sout[(size_t)(ks * 8 + 2 * e + 1) * 128 + col] = S2[e][1]; }
    bar_sync();
}
#define SAMPLE_LOOP(TYPE, LOADF, RUNF, NITEMS) do { int x_ = blockIdx.x; if (x_ < (NITEMS)) { TYPE a_; LOADF(P, i, x_, lane, wave, a_); \
        for (;;) { const int xn_ = x_ + G; const bool more_ = xn_ < (NITEMS); TYPE b_; if (more_) LOADF(P, i, xn_, lane, wave, b_); RUNF(P, i, x_, lane, wave, a_); if (!more_) break; a_ = b_; x_ = xn_; } } } while (0)
DEVINL void phase_scan_ab(const Params& P, int i, LAS unsigned char* lds, int tid, int lane, int wave, int G) {
    REP(10) for (int it = blockIdx.x; it < 256; it += G) {
        if (it < 128) { const int b = it >> 4, h = (it >> 2) & 3, g = it & 3;
            gla_item_lds(P, lds, b * TP, TP, h, g, P.out + O_PGLA + (((size_t)i * NBP + b) * 4 + h) * 8192, tid, lane, wave);
        } else { const int x = it - 128, b = x >> 4, h = (x >> 1) & 7, rg = x & 1;
            rwkv_item_lds(P, lds, b * TP, TP, h, rg, P.out + O_PRWKV + (((size_t)i * NBP + b) * 8 + h) * 4096, tid, lane, wave);
        }
    }
    REP(11) { SAMPLE_LOOP(GlaS, gla_s_load, gla_s_run, 2048);
    SAMPLE_LOOP(RwS, rw_s_load, rw_s_run, 2048); }
}
DEVINL void phase_post_ab(const Params& P, int i, int gw, int ngw, int lane) {
    const half_t* Z = (const half_t*)(P.ws + WS_Z); const half_t* OG = (const half_t*)(P.ws + WS_OG); const half_t* YR = (const half_t*)(P.ws + WS_YR);
    const half_t* RPH = (const half_t*)(P.ws + WS_RPH); const float* BON = (const float*)(P.ws + WS_BON); half_t* MO = (half_t*)(P.ws + WS_MO);
    const float* ng = P.in[12] + i * 512; const float* lg = P.in[22] + i * 512; const float* lb = P.in[23] + i * 512;
    for (int row = gw; row < NT; row += ngw) {
#pragma unroll
        for (int h = 0; h < 4; ++h) {
            const int c = h * 128 + lane * 2;
            const h2 o = *(const h2*)(OG + (size_t)row * 512 + c); const float o0 = (float)o[0], o1 = (float)o[1];
            const float rs = rsqrtf(wave_sum(o0 * o0 + o1 * o1) * (1.f / 128.f) + 1e-6f);
            const h2 og = *(const h2*)(Z + (size_t)row * LDZ_AB + 1024 + c);
            h2 r; r[0] = (half_t)(o0 * rs * ng[c] * siluf_((float)og[0])); r[1] = (half_t)(o1 * rs * ng[c + 1] * siluf_((float)og[1]));
            *(h2*)(MO + (size_t)row * D + c) = r;
        }
#pragma unroll
        for (int h = 0; h < 8; ++h) {
            const int c = h * 64 + lane;
            const float y = (float)YR[(size_t)row * 512 + c];
            const float m = wave_sum(y) * (1.f / 64.f); const float d = y - m; const float var = wave_sum(d * d) * (1.f / 64.f);
            const float yn = d * rsqrtf(var + 64e-5f) * lg[c] + lb[c];
            const float v = (float)RPH[(size_t)row * 3072 + 1024 + c], gate = (float)RPH[(size_t)row * 3072 + 2560 + c];
            MO[(size_t)row * D + 512 + c] = (half_t)((yn + BON[(size_t)row * 8 + h] * v) * gate);
        }
    }
}

DEVINL void gdn_conv8(const half_t* zr, const float* cw, const float* cst, int t, int sb, int c, float (&o)[8]) {
    float x[8], w[8];
    ld_h8f(zr + c, x); ld_f8(cw + (size_t)3 * 3072 + c, w);
#pragma unroll
    for (int e = 0; e < 8; ++e) o[e] = w[e] * x[e];
#pragma unroll
    for (int d = 1; d < 4; ++d) {
        bool have = true;
        if (t >= d) ld_h8f(zr - (size_t)d * LDZ_C + c, x);
        else if (sb >= 0) ld_f8(cst + ((size_t)sb * 3 + (3 + t - d)) * 3072 + c, x);
        else have = false;
        if (have) { ld_f8(cw + (size_t)(3 - d) * 3072 + c, w);
#pragma unroll
            for (int e = 0; e < 8; ++e) o[e] += w[e] * x[e]; }
    }
#pragma unroll
    for (int e = 0; e < 8; ++e) o[e] = siluf_(o[e]);
}
DEVINL void phase_prep_c(const Params& P, int i, int gw, int ngw, int lane) {
    const half_t* Z = (const half_t*)(P.ws + WS_Z);
    half_t* GQ = (half_t*)(P.ws + WS_GQ); half_t* GK = (half_t*)(P.ws + WS_GK); half_t* GV = (half_t*)(P.ws + WS_GV); float* GS = (float*)(P.ws + WS_GS);
    const float* cw = P.in[26] + (size_t)i * 4 * 3072; const float* alog = P.in[27] + i * 8; const float* dtb = P.in[28] + i * 8; const float* cst = P.in[6] + (size_t)i * NBS * 3 * 3072;
    for (int row = gw; row < NT; row += ngw) {
        int t, sb; row_info(row, t, sb);
        const half_t* zr = Z + (size_t)row * LDZ_C;
#pragma unroll
        for (int hf = 0; hf < 2; ++hf) {
            const int c = hf * 512 + lane * 8;
            float q[8], k[8], v[8];
            gdn_conv8(zr, cw, cst, t, sb, c, q); gdn_conv8(zr, cw, cst, t, sb, 1024 + c, k); gdn_conv8(zr, cw, cst, t, sb, 2048 + c, v);
            float sq = 0.f, sk = 0.f;
#pragma unroll
            for (int e = 0; e < 8; ++e) { sq += q[e] * q[e]; sk += k[e] * k[e]; }
            sq = red16(sq); sk = red16(sk);
            const float qs = rsqrtf(sq + 1e-6f) * 0.08838834764831845f, kss = rsqrtf(sk + 1e-6f);
            float qk = 0.f; h8 qo, ko, vo;
#pragma unroll
            for (int e = 0; e < 8; ++e) { q[e] *= qs; k[e] *= kss; qk += q[e] * k[e]; qo[e] = (half_t)q[e]; ko[e] = (half_t)k[e]; vo[e] = (half_t)v[e]; }
            qk = red16(qk);
            *(h8*)(GQ + (size_t)row * 1024 + c) = qo; *(h8*)(GK + (size_t)row * 1024 + c) = ko; *(h8*)(GV + (size_t)row * 1024 + c) = vo;
            if ((lane & 15) == 0) {
                const int h = hf * 4 + (lane >> 4);
                const float bl = (float)zr[4096 + h], al = (float)zr[4104 + h];
                const float x = al + dtb[h]; const float sp = x > 20.f ? x : log1pf(__expf(x));
                const float g = -__expf(alog[h]) * sp;
                *(f32x4*)(GS + ((size_t)row * 8 + h) * 4) = (f32x4){sigmoidf_(bl), __expf(g), qk, 0.f};
            }
        }
    }
    for (int q = gw; q < NSEQ * 3; q += ngw) {
        const int s = q / 3, j = q - s * 3;
        const int row = s < NBP ? s * TP + TP - 3 + j : NTP + (s - NBP) * 4 + 1 + j;
        float* dst = s < NBP ? P.out + O_PGDNCONV + (((size_t)i * NBP + s) * 3 + j) * 3072 : P.out + O_SGDNCONV + (((size_t)i * NBS + (s - NBP)) * 3 + j) * 3072;
        for (int p = 0; p < 12; ++p) { const int c = p * 256 + lane * 4; *(f32x4*)(dst + c) = ld_h4(Z + (size_t)row * LDZ_C + c); }
    }
}
struct GdnS { float S[8]; h8 q[4], k[4]; half_t v[4]; f32x4 sc[4]; };
DEVINL void gdn_s_load(const Params& P, int i, int x, int lane, int wave, GdnS& r) {
    const half_t* GQ = (const half_t*)(P.ws + WS_GQ); const half_t* GK = (const half_t*)(P.ws + WS_GK); const half_t* GV = (const half_t*)(P.ws + WS_GV); const float* GS = (const float*)(P.ws + WS_GS);
    const int sb = x >> 5, h = (x >> 2) & 7, g = x & 3, col = g * 32 + wave * 4 + (lane >> 4), ks = lane & 15, row0 = NTP + sb * 4;
    const float* s0 = P.in[5] + (((size_t)i * NBS + sb) * 8 + h) * 16384;
#pragma unroll
    for (int e = 0; e < 8; ++e) r.S[e] = s0[(size_t)(ks * 8 + e) * 128 + col];
#pragma unroll
    for (int u = 0; u < 4; ++u) { const size_t ro = (size_t)(row0 + u) * 1024 + h * 128;
        r.q[u] = *(const h8*)(GQ + ro + ks * 8); r.k[u] = *(const h8*)(GK + ro + ks * 8); r.v[u] = GV[ro + col]; r.sc[u] = *(const f32x4*)(GS + ((size_t)(row0 + u) * 8 + h) * 4); }
}
DEVINL void gdn_s_run(const Params& P, int i, int x, int lane, int wave, GdnS& r) {
    half_t* OD = (half_t*)(P.ws + WS_OD);
    const int sb = x >> 5, h = (x >> 2) & 7, g = x & 3, col = g * 32 + wave * 4 + (lane >> 4), ks = lane & 15, row0 = NTP + sb * 4;
    float* sout = P.out + O_SGDN + (((size_t)i * NBS + sb) * 8 + h) * 16384;
#pragma unroll
    for (int u = 0; u < 4; ++u) {
        float d1 = 0.f, d2 = 0.f;
#pragma unroll
        for (int e = 0; e < 8; ++e) { d1 += r.S[e] * (float)r.k[u][e]; d2 += r.S[e] * (float)r.q[u][e]; }
        d1 = red16(d1); d2 = red16(d2);
        const float beta = r.sc[u][0], eg = r.sc[u][1], qk = r.sc[u][2];
        const float uu = beta * ((float)r.v[u] - eg * d1);
#pragma unroll
        for (int e = 0; e < 8; ++e) r.S[e] = eg * r.S[e] + (float)r.k[u][e] * uu;
        if (ks == 0) OD[(size_t)(row0 + u) * 1024 + h * 128 + col] = (half_t)(eg * d2 + qk * uu);
    }
#pragma unroll
    for (int e = 0; e < 8; ++e) sout[(size_t)(ks * 8 + e) * 128 + col] = r.S[e];
}
DEVINL void phase_scan_c(const Params& P, int i, LAS unsigned char* lds, int tid, int lane, int wave, int G) {
    REP(10) for (int it = blockIdx.x; it < 256; it += G) { const int b = it >> 5, h = (it >> 2) & 7, g = it & 3;
        gdn_item_lds(P, lds, b * TP, TP, h, g, P.out + O_PGDN + (((size_t)i * NBP + b) * 8 + h) * 16384, tid, lane, wave); }
    REP(11) SAMPLE_LOOP(GdnS, gdn_s_load, gdn_s_run, 4096);
}
DEVINL void phase_post_c(const Params& P, int i, int gw, int ngw, int lane) {
    const half_t* Z = (const half_t*)(P.ws + WS_Z); const half_t* OD = (const half_t*)(P.ws + WS_OD); half_t* MO = (half_t*)(P.ws + WS_MO);
    const float* ng = P.in[29] + i * 128;
    const float g0 = ng[lane * 2], g1 = ng[lane * 2 + 1];
    for (int row = gw; row < NT; row += ngw) {
#pragma unroll
        for (int h = 0; h < 8; ++h) {
            const int c = h * 128 + lane * 2;
            const h2 o = *(const h2*)(OD + (size_t)row * 1024 + c); const float o0 = (float)o[0], o1 = (float)o[1];
            const float rs = rsqrtf(wave_sum(o0 * o0 + o1 * o1) * (1.f / 128.f) + 1e-6f);
            const h2 zg = *(const h2*)(Z + (size_t)row * LDZ_C + 3072 + c);
            h2 r; r[0] = (half_t)(o0 * rs * g0 * siluf_((float)zg[0])); r[1] = (half_t)(o1 * rs * g1 * siluf_((float)zg[1]));
            *(h2*)(MO + (size_t)row * D + c) = r;
        }
    }
}

#define GAS __attribute__((address_space(1)))
#define XB_TMO      128
#define XB_XCNT(j)  (256  + 64 * (j))
#define XB_XSUB(j)  (1280 + 64 * (j))
#define XB_XGEN(j)  (2304 + 64 * (j))
#define XB_TOP      3328
#define XB_TOPGEN   3392
#define XCD_BAR_WORDS 3456
#define XB_SPIN_CAP (1u << 18)

__device__ __forceinline__ unsigned xb_ld(unsigned* p)              { return __hip_atomic_load(p, __ATOMIC_RELAXED, __HIP_MEMORY_SCOPE_AGENT); }
__device__ __forceinline__ unsigned xb_add(unsigned* p, unsigned v) { return __hip_atomic_fetch_add(p, v, __ATOMIC_RELAXED, __HIP_MEMORY_SCOPE_AGENT); }
__device__ __forceinline__ unsigned xb_xcc_id() { return (unsigned)__builtin_amdgcn_s_getreg((3 << 11) | 20) & 0xFu; }
#define XB_SPIN(cond, bar) do { unsigned _sp = 0; while (cond) { __builtin_amdgcn_s_sleep(1); \
    if ((++_sp & 255u) == 0u) { if (xb_ld(&(bar)[XB_TMO])) break; if (_sp > XB_SPIN_CAP) { atomicAdd(&(bar)[XB_TMO], 1u); break; } } } } while (0)

struct XcdBarrier {
    unsigned* bar; unsigned x;
    volatile LAS unsigned* st;
};

__device__ __forceinline__ XcdBarrier xcd_barrier_post(unsigned* bar, volatile LAS unsigned* st) {
    XcdBarrier b; b.bar = bar; b.x = xb_xcc_id(); b.st = st;
    if (threadIdx.x == 0) (void)xb_add(&bar[XB_XCNT(b.x)], 1u);
    return b;
}
__device__ __forceinline__ void xcd_barrier_complete(unsigned* bar, unsigned x, unsigned& nloc, unsigned& nx) {
    const unsigned G = gridDim.x * gridDim.y * gridDim.z;
    unsigned sum, cnt, mine, sp = 0u;
    for (;;) {
        sum = 0u; cnt = 0u; mine = 0u;
#pragma unroll
        for (unsigned j = 0; j < 16; ++j) { const unsigned c = xb_ld(&bar[XB_XCNT(j)]); sum += c; cnt += (c > 0u) ? 1u : 0u; mine = (j == x) ? c : mine; }
        if (sum == G) break;
        __builtin_amdgcn_s_sleep(1);
        if ((++sp & 255u) == 0u) { if (xb_ld(&bar[XB_TMO])) break; if (sp > XB_SPIN_CAP) { atomicAdd(&bar[XB_TMO], 1u); break; } }
    }
    nloc = mine > 0u ? mine : 1u; nx = cnt > 0u ? cnt : 1u;
}

__device__ __forceinline__ void xcd_barrier(const XcdBarrier& b) {
    asm volatile("s_waitcnt vmcnt(0)" ::: "memory");
    bar_sync();
    if (threadIdx.x == 0) {
        unsigned* bar = b.bar;
        __builtin_amdgcn_s_waitcnt(0);
        unsigned nloc = b.st[0], nx = b.st[1];
        if (nloc == 0u) { xcd_barrier_complete(bar, b.x, nloc, nx); b.st[0] = nloc; b.st[1] = nx; }
        const unsigned old = xb_add(&bar[XB_XSUB(b.x)], 1u);
        const unsigned gen = old / nloc;
        if (old + 1u == (gen + 1u) * nloc) {
            __builtin_amdgcn_fence(__ATOMIC_RELEASE, "agent");
            asm volatile("s_waitcnt vmcnt(0)" ::: "memory");
            const unsigned og = xb_add(&bar[XB_TOP], 1u);
            const unsigned tg = og / nx;
            if (og + 1u == (tg + 1u) * nx) xb_add(&bar[XB_TOPGEN], 1u);
            else XB_SPIN(xb_ld(&bar[XB_TOPGEN]) == tg, bar);
            __builtin_amdgcn_fence(__ATOMIC_ACQUIRE, "agent");
            xb_add(&bar[XB_XGEN(b.x)], 1u);
            asm volatile("s_waitcnt vmcnt(0)" ::: "memory");
        } else {
            XB_SPIN(xb_ld(&bar[XB_XGEN(b.x)]) == gen, bar);
            __builtin_amdgcn_fence(__ATOMIC_ACQUIRE, "agent");
            asm volatile("s_waitcnt vmcnt(0)" ::: "memory");
        }
    }
    bar_sync();
}


constexpr int N_PHASES = 41;
#if defined(__HIP_DEVICE_COMPILE__)
#define NO_PK_F32 __attribute__((target("no-packed-fp32-ops")))
#else
#define NO_PK_F32
#endif
__global__ void __launch_bounds__(NTHREADS, 2) NO_PK_F32 mega_fwd(Params P) {
    extern __shared__ __attribute__((aligned(16))) unsigned char lds_raw[];
    LAS unsigned char* lds = (LAS unsigned char*)lds_raw;
#if !MK_MULTI
    cg::grid_group grid = cg::this_grid();
    volatile LAS unsigned* bar_st = (volatile LAS unsigned*)(lds + 132096);
    if (threadIdx.x < 2) bar_st[threadIdx.x] = 0u;
    bar_sync();
    const XcdBarrier gbar = xcd_barrier_post((unsigned*)(P.ws + 4096), bar_st);
#define SEAM(k) do { if ((k) + 1 < N_PHASES) { if ((k) == 0) grid.sync(); else xcd_barrier(gbar); } } while (0)
#else
#define SEAM(k) do { } while (0)
#endif
#if MK_MULTI
#define IN(k) (P.ph_lo <= (k) && (k) < P.ph_hi)
#else
#define IN(k) true
#endif
#define PHASE_LOCALS() int tid = threadIdx.x, bid = blockIdx.x, G = gridDim.x; asm volatile("" : "+v"(tid), "+s"(bid), "+s"(G)); (void)bid; \
    const int lane = tid & 63, wave = __builtin_amdgcn_readfirstlane(tid >> 6), gw = bid * NWAVES + wave, ngw = G * NWAVES; (void)lane; (void)gw; (void)ngw;
    { PHASE_LOCALS();
      if (IN(0)) { phase_prologue(P, gw, ngw, lane); convert_layer_weights(P, 0, lds, gw, ngw, lane, wave); SEAM(0); } }
#pragma unroll 1
    for (int l = 0; l < 4; ++l) {
        const int base = 1 + l * 10, i = l >> 1; const bool even = (l & 1) == 0;
        const int ldz = even ? LDZ_AB : LDZ_C;
        { PHASE_LOCALS();
        if (IN(base + 0)) {
            pg8::Gemm g{(half_t*)(P.ws + WS_XB), (half_t*)(P.ws + WS_WIN), MP, ldz, D}; pg8::StaticOrder S; S.init(MP, ldz, G, bid);
            pg8::EpiZ E{(half_t*)(P.ws + WS_Z), ldz};
            REP(0) pg8::gemm_phase<pg8::EpiZ, pg8::StaticOrder, true, true>(lds, g, S, E, tid);
            SEAM(base + 0);
        } }
        { PHASE_LOCALS(); if (IN(base + 1)) { REP(1) if (even) phase_prep_ab(P, i, lds, tid, lane, wave, G); else phase_prep_c(P, i, gw, ngw, lane); SEAM(base + 1); } }
        { PHASE_LOCALS(); if (IN(base + 2)) { REP(2) if (even) phase_scan_ab(P, i, lds, tid, lane, wave, G); else phase_scan_c(P, i, lds, tid, lane, wave, G); SEAM(base + 2); } }
        { PHASE_LOCALS(); if (IN(base + 3)) { REP(3) if (even) phase_post_ab(P, i, gw, ngw, lane); else phase_post_c(P, i, gw, ngw, lane); zero_xacc(P, gw, ngw, lane); SEAM(base + 3); } }
        { PHASE_LOCALS();
        if (IN(base + 4)) {
            pg8::Gemm g{(half_t*)(P.ws + WS_MO), (half_t*)(P.ws + WS_WOUT), MP, D, D};
            pg8::EpiRes E{(float*)(P.ws + WS_X), ALPHA, (float*)(P.ws + WS_XACC)};
            pg8::SplitOrder S; S.init(D, G, bid);
            pg8::gemm_phase<pg8::EpiRes, pg8::SplitOrder, true, true>(lds, g, S, E, tid);
            SEAM(base + 4);
        } }
        { PHASE_LOCALS(); if (IN(base + 5)) { if ((PROBE_MASK >> 5) & 1) phase_ln(P, P.in[35] + l * D, P.in[36] + l * D, false, -1, gw, ngw, lane, true); phase_ln(P, P.in[35] + l * D, P.in[36] + l * D, false, -1, gw, ngw, lane); SEAM(base + 5); } }
        { PHASE_LOCALS();
        if (IN(base + 6)) {
            pg8::Gemm g{(half_t*)(P.ws + WS_XB), (half_t*)(P.ws + WS_WUP), MP, LDH, D}; pg8::StaticOrder S; S.init(MP, LDH, G, bid);
            pg8::EpiZ E{(half_t*)(P.ws + WS_Z), LDH};
            REP(6) pg8::gemm_phase<pg8::EpiZ, pg8::StaticOrder, true, true>(lds, g, S, E, tid);
            SEAM(base + 6);
        } }
        { PHASE_LOCALS(); if (IN(base + 7)) { REP(7) phase_act(P, l, gw, ngw, lane); zero_xacc(P, gw, ngw, lane); SEAM(base + 7); } }
        { PHASE_LOCALS();
        if (IN(base + 8)) {
            pg8::Gemm g{(half_t*)(P.ws + WS_MO), (half_t*)(P.ws + WS_WDN), MP, D, DFF};
            pg8::EpiRes E{(float*)(P.ws + WS_X), ALPHA, (float*)(P.ws + WS_XACC)};
            pg8::SplitOrder S; S.init(DFF, G, bid);
            pg8::gemm_phase<pg8::EpiRes, pg8::SplitOrder, true, true>(lds, g, S, E, tid);
            SEAM(base + 8);
        } }
        { PHASE_LOCALS();
        if (IN(base + 9)) {
            phase_ln(P, P.in[37] + l * D, P.in[38] + l * D, l == 3, l == 1 ? 1 : -1, gw, ngw, lane);
            if (l < 3) convert_layer_weights(P, l + 1, lds, gw, ngw, lane, wave);
            SEAM(base + 9);
        } }
    }
#undef IN
#undef SEAM
}

extern "C" void kernel_launch(void* const* d_in, const int* in_sizes, int n_in, void* d_out, int out_size, void* d_ws, size_t ws_size, hipStream_t stream) {
    static int grid = 0;
    if (grid == 0) {
        if (n_in != 39 || (size_t)out_size != O_END || ws_size < WS_END) { fprintf(stderr, "kernel_launch: unexpected problem (n_in %d, out %d, ws %zu); nothing launched\n", n_in, out_size, ws_size); grid = -1; return; }
        int dev = 0, cus = 0, per_cu = 0;
        if (hipGetDevice(&dev) != hipSuccess || hipDeviceGetAttribute(&cus, hipDeviceAttributeMultiprocessorCount, dev) != hipSuccess) { grid = -1; return; }
        if (hipFuncSetAttribute((const void*)mega_fwd, hipFuncAttributeMaxDynamicSharedMemorySize, LDS_BYTES) != hipSuccess) { fprintf(stderr, "kernel_launch: hipFuncSetAttribute failed\n"); grid = -1; return; }
        if (hipOccupancyMaxActiveBlocksPerMultiprocessor(&per_cu, (const void*)mega_fwd, NTHREADS, LDS_BYTES) != hipSuccess || per_cu < 1) { fprintf(stderr, "kernel_launch: occupancy query says %d blocks per CU\n", per_cu); (void)hipGetLastError(); grid = -1; return; }
        if (cus != 256) { fprintf(stderr, "kernel_launch: built for a 256-CU device (got %d)\n", cus); grid = -1; return; }
        grid = cus;
    }
    if (grid < 0) return;
    if (hipMemsetAsync(d_ws, 0, 65536, stream) != hipSuccess) { fprintf(stderr, "kernel_launch: hipMemsetAsync failed\n"); return; }
    Params p{};
    for (int k = 0; k < 39; ++k) p.in[k] = (const float*)d_in[k];
    p.out = (float*)d_out; p.ws = (unsigned char*)d_ws;
#if MK_MULTI
    for (int k = 0; k < N_PHASES; ++k) { p.ph_lo = k; p.ph_hi = k + 1; hipLaunchKernelGGL(mega_fwd, dim3(grid), dim3(NTHREADS), LDS_BYTES, stream, p); }
#else
    p.ph_lo = 0; p.ph_hi = N_PHASES;
    void* args[] = {&p};
    const hipError_t e = hipLaunchCooperativeKernel((const void*)mega_fwd, dim3(grid), dim3(NTHREADS), args, LDS_BYTES, stream);
    if (e != hipSuccess) fprintf(stderr, "kernel_launch: cooperative launch failed: %s (grid %d)\n", hipGetErrorString(e), grid);
#endif
}
```

```cpp
#include <hip/hip_runtime.h>
#include <hip/hip_cooperative_groups.h>
#include <cstdio>
#include <cstdint>
namespace cg = cooperative_groups;

#ifndef MK_MULTI
#define MK_MULTI 0
#endif

namespace pg8 {
#define PG8_LAS __attribute__((address_space(3)))
typedef _Float16 bf16_t;
typedef _Float16 bf16x8 __attribute__((ext_vector_type(8)));
typedef float f32x4 __attribute__((ext_vector_type(4)));
typedef unsigned u32x4 __attribute__((ext_vector_type(4)));
constexpr int BM = 256, BK = 64, HALF = 128, HTB = HALF * BK * 2  , STAGE_BYTES = 8 * HTB, NXCD = 8, WGM = 8;

__host__ __device__ __forceinline__ int lds_byte(int r, int c) { const int st = (r >> 4) * 2 + (c >> 5), rr = r & 15, cc = c & 31, ob = rr * 64 + cc * 2; return st * 1024 + (ob ^ (((ob >> 9) & 1) << 5)); }
__host__ __device__ __forceinline__ void stage_rc(int b, int& R, int& C) { const int st = b / 1024, sb = b % 1024, swz = sb ^ (((sb >> 9) & 1) << 5); R = (st >> 1) * 16 + swz / 64; C = (st & 1) * 32 + (swz % 64) / 2; }
__host__ __device__ __forceinline__ int perm32(int rho) { const int n = rho >> 4, i = rho & 15; return 8 * (i >> 2) + 4 * n + (i & 3); }

struct Unit { int pm, pn, kt0, nkt, part; };
struct Gemm { const bf16_t* A; const bf16_t* Bt; int M, N, K; };

struct StaticOrder {
    int nM, nN, nwg, G, c, nkt;
    __host__ __device__ __forceinline__ void init(int M, int N, int G_, int c_, int K_ = 1024) { nM = M / BM; nN = N / BM; nwg = nM * nN; G = G_; c = c_; nkt = K_ / BK; }
    __host__ __device__ __forceinline__ bool next(int i, Unit& u) const {
        const long L = (long)i * G + c; if (L >= nwg) return false;
        int wgid = (int)L; { const int q = nwg / NXCD, r = nwg % NXCD, xcd = wgid % NXCD, off = wgid / NXCD; wgid = (xcd < r ? xcd * (q + 1) : r * (q + 1) + (xcd - r) * q) + off; }
        const int nig = WGM * nN, gid = wgid / nig, fm = gid * WGM, gsz = (nM - fm) < WGM ? (nM - fm) : WGM;
        u.pm = fm + ((wgid % nig) % gsz); u.pn = (wgid % nig) / gsz; u.kt0 = 0; u.nkt = nkt; u.part = 0; return true;
    }
    __device__ __forceinline__ void a_ready(const Unit&) const {}
    __device__ __forceinline__ void done(const Unit&) const {}
};
struct SplitOrder {
    StaticOrder S0; int c, nkt, pk, ppu, npieces;
    __host__ __device__ __forceinline__ void init(int K, int G_, int c_) { S0.init(16384, 1024, G_, c_, K); c = c_; nkt = K / BK; pk = (nkt % 4 == 0 && nkt > 16) ? 4 : 2; ppu = nkt / pk; npieces = 12 * ppu; }
    __host__ __device__ __forceinline__ bool next(int i, Unit& u) const {
        if (i == 0) return S0.next(0, u);
        if (i == 1 && c < npieces) { const int lu = c / ppu, p = c - lu * ppu; u.pm = 64 + (lu >> 2); u.pn = lu & 3; u.kt0 = p * pk; u.nkt = pk; u.part = p + 1; return true; }
        return false;
    }
    __device__ __forceinline__ void a_ready(const Unit&) const {}
    __device__ __forceinline__ void done(const Unit&) const {}
};

struct EpiZ {
    static constexpr bool PERM = true, AFTER_DRAIN = false;
    bf16_t* O; int ldc;
    __device__ __forceinline__ void operator()(const f32x4 (&acc)[2][2][4][2], const Unit& u, int wr, int wc, int fr, int fq) const {
        const int row0 = u.pm * BM + wr * 64 + fr, col0 = u.pn * BM + wc * 32 + 8 * fq;
#pragma unroll
        for (int ai = 0; ai < 2; ++ai)
#pragma unroll
            for (int m = 0; m < 4; ++m) { bf16_t* rowp = O + (size_t)(row0 + ai * HALF + m * 16) * ldc + col0;
#pragma unroll
                for (int bj = 0; bj < 2; ++bj) { const f32x4 v0 = acc[ai][bj][m][0], v1 = acc[ai][bj][m][1];
                    bf16x8 w; w[0] = (bf16_t)v0[0]; w[1] = (bf16_t)v0[1]; w[2] = (bf16_t)v0[2]; w[3] = (bf16_t)v0[3]; w[4] = (bf16_t)v1[0]; w[5] = (bf16_t)v1[1]; w[6] = (bf16_t)v1[2]; w[7] = (bf16_t)v1[3];
                    *(bf16x8*)(rowp + bj * HALF) = w; } }
    }
};
struct EpiRes {
    static constexpr bool PERM = false, AFTER_DRAIN = false;
    float* X; float alpha; float* XACC;
    __device__ __forceinline__ void operator()(const f32x4 (&acc)[2][2][4][2], const Unit& u, int wr, int wc, int fr, int fq) const {
        const int col0 = u.pn * BM + wc * 32 + 4 * fq;
        if (u.part) {
            const int row0 = (u.pm - 64) * BM + wr * 64 + fr; float* slab = XACC + (size_t)(u.part - 1) * 768 * 1024;
#pragma unroll
            for (int ai = 0; ai < 2; ++ai)
#pragma unroll
                for (int m = 0; m < 4; ++m) { float* rowp = slab + (size_t)(row0 + ai * HALF + m * 16) * 1024 + col0;
#pragma unroll
                    for (int bj = 0; bj < 2; ++bj)
#pragma unroll
                        for (int n = 0; n < 2; ++n) *(f32x4*)(rowp + bj * HALF + n * 16) = acc[ai][bj][m][n]; }
            return;
        }
        const int row0 = u.pm * BM + wr * 64 + fr;
#pragma unroll
        for (int ai = 0; ai < 2; ++ai)
#pragma unroll
            for (int m = 0; m < 4; ++m) { float* rowp = X + (size_t)(row0 + ai * HALF + m * 16) * 1024 + col0;
#pragma unroll
                for (int bj = 0; bj < 2; ++bj)
#pragma unroll
                    for (int n = 0; n < 2; ++n) { f32x4* p = (f32x4*)(rowp + bj * HALF + n * 16); const f32x4 x = *p; *p = x * alpha + acc[ai][bj][m][n]; } }
    }
};

template <class Epi, class Sched, bool ALIGN_EPI = false, bool SP2 = false>
__device__ __forceinline__ void gemm_phase(PG8_LAS unsigned char* lds, const Gemm g, const Sched& S, const Epi& E, const int tid) {
    const int wid = __builtin_amdgcn_readfirstlane(tid >> 6), lane = tid & 63, wr = wid >> 2, wc = wid & 3, fr = lane & 15, fq = lane >> 4;
    const int K = g.K;
    unsigned voffA[2], voffB[2];
#pragma unroll
    for (int i = 0; i < 2; ++i) { int R, C; stage_rc(tid * 16 + i * 8192, R, C); const int Rb = Epi::PERM ? ((R & ~31) + perm32(R & 31)) : R;
        voffA[i] = (unsigned)(R * K + C) * 2u; voffB[i] = (unsigned)(Rb * K + C) * 2u; }
    const size_t kstep = (size_t)(BK * 2);
    const size_t hstep = (size_t)HALF * K * 2;
    const size_t tstep = 2 * hstep;
    const unsigned ldsw = (unsigned)wid * 1024u;
    const int aoff = lds_byte(wr * 64 + fr, fq * 8), boff = lds_byte(wc * 32 + fr, fq * 8);
#define PG8_SA(b, h) (((b) * 2 + (h)) * HTB)
#define PG8_SB(b, h) ((4 + (b) * 2 + (h)) * HTB)
#define PG8_STAGE(bufoff, gbase, voff) do { _Pragma("unroll") for (int _i = 0; _i < 2; ++_i) \
        __builtin_amdgcn_global_load_lds((const unsigned*)((const char*)(gbase) + (voff)[_i]), (PG8_LAS unsigned*)(lds + (bufoff) + ldsw + _i * 8192), 16, 0, 0); } while (0)
#define PG8_LDA(dst, b, h) do { _Pragma("unroll") for (int m = 0; m < 4; ++m) _Pragma("unroll") for (int k = 0; k < 2; ++k) dst[m][k] = *(const PG8_LAS bf16x8*)(lds + PG8_SA(b, h) + aoff + m * 2048 + k * 1024); } while (0)
#define PG8_LDB(dst, b, h) do { _Pragma("unroll") for (int n = 0; n < 2; ++n) _Pragma("unroll") for (int k = 0; k < 2; ++k) dst[n][k] = *(const PG8_LAS bf16x8*)(lds + PG8_SB(b, h) + boff + n * 2048 + k * 1024); } while (0)
#define PG8_MMA(ai, bj, At, Bt) do { __builtin_amdgcn_s_setprio(1); _Pragma("unroll") for (int m = 0; m < 4; ++m) _Pragma("unroll") for (int n = 0; n < 2; ++n) _Pragma("unroll") for (int k = 0; k < 2; ++k) \
        acc[ai][bj][m][n] = __builtin_amdgcn_mfma_f32_16x16x32_f16(Bt[n][k], At[m][k], acc[ai][bj][m][n], 0, 0, 0); __builtin_amdgcn_s_setprio(0); } while (0)
#define PG8_WAIT_V(n) asm volatile("s_waitcnt vmcnt(" #n ")" ::: "memory")
#define PG8_WAIT_L(n) asm volatile("s_waitcnt lgkmcnt(" #n ")" ::: "memory")
#define PG8_BAR __builtin_amdgcn_s_barrier()
#define PG8_SCHED __builtin_amdgcn_sched_barrier(0)
    Unit cur, nxt; int ui = 0;
    if (!S.next(0, cur)) return;
    f32x4 acc[2][2][4][2];
#pragma unroll
    for (int a = 0; a < 2; ++a)
#pragma unroll
        for (int b = 0; b < 2; ++b)
#pragma unroll
            for (int m = 0; m < 4; ++m)
#pragma unroll
                for (int n = 0; n < 2; ++n) acc[a][b][m][n] = (f32x4){0.f, 0.f, 0.f, 0.f};
    bf16x8 At[4][2], B0[2][2], B1[2][2];
    const char* cA = (const char*)g.A + (size_t)cur.pm * tstep + (size_t)cur.kt0 * kstep; const char* cB = (const char*)g.Bt + (size_t)cur.pn * tstep + (size_t)cur.kt0 * kstep;
    S.a_ready(cur);
    if constexpr (SP2) {
        PG8_STAGE(PG8_SB(0, 0), cB, voffB); PG8_STAGE(PG8_SB(0, 1), cB + hstep, voffB); PG8_STAGE(PG8_SA(0, 0), cA, voffA); PG8_STAGE(PG8_SA(0, 1), cA + hstep, voffA);
        if (wr == 1) PG8_BAR;
        PG8_WAIT_V(2); PG8_BAR;
        PG8_STAGE(PG8_SB(1, 0), cB + kstep, voffB); PG8_STAGE(PG8_SA(1, 0), cA + kstep, voffA); PG8_STAGE(PG8_SB(1, 1), cB + hstep + kstep, voffB);
        PG8_WAIT_V(6); PG8_BAR;
    } else {
        PG8_STAGE(PG8_SB(0, 0), cB, voffB); PG8_STAGE(PG8_SA(0, 0), cA, voffA); PG8_STAGE(PG8_SB(0, 1), cB + hstep, voffB); PG8_STAGE(PG8_SA(0, 1), cA + hstep, voffA);
        if (wr == 1) PG8_BAR;
        PG8_WAIT_V(4); PG8_BAR;
        PG8_STAGE(PG8_SB(1, 0), cB + kstep, voffB); PG8_STAGE(PG8_SA(1, 0), cA + kstep, voffA); PG8_STAGE(PG8_SB(1, 1), cB + hstep + kstep, voffB);
        PG8_WAIT_V(6); PG8_BAR;
    }
    for (;;) {
        const bool has_next = S.next(ui + 1, nxt);
        const char* nA = has_next ? (const char*)g.A + (size_t)nxt.pm * tstep + (size_t)nxt.kt0 * kstep : cA; const char* nB = has_next ? (const char*)g.Bt + (size_t)nxt.pn * tstep + (size_t)nxt.kt0 * kstep : cB;
        const int nt = cur.nkt;
        for (int t = 0; t < nt; t += 2) {
            const bool last = (t == nt - 2);
            const char* a1 = cA + (size_t)(t + 1) * kstep;
            const char* a2 = last ? nA : cA + (size_t)(t + 2) * kstep; const char* b2 = last ? nB : cB + (size_t)(t + 2) * kstep;
            const char* a3 = a2 + kstep; const char* b3 = b2 + kstep;
            if (last && has_next) S.a_ready(nxt);
            if constexpr (SP2) {
            PG8_LDB(B0, 0, 0); PG8_LDB(B1, 0, 1); PG8_SCHED; PG8_LDA(At, 0, 0); PG8_STAGE(PG8_SA(1, 1), a1 + hstep, voffA);
            PG8_WAIT_V(8); PG8_WAIT_L(0); PG8_BAR; PG8_MMA(0, 0, At, B0); PG8_MMA(0, 1, At, B1); PG8_BAR; PG8_SCHED;
            PG8_LDA(At, 0, 1); PG8_STAGE(PG8_SB(0, 0), b2, voffB); PG8_STAGE(PG8_SB(0, 1), b2 + hstep, voffB); PG8_STAGE(PG8_SA(0, 0), a2, voffA);
            PG8_WAIT_V(8); PG8_WAIT_L(0); PG8_BAR; PG8_MMA(1, 0, At, B0); PG8_MMA(1, 1, At, B1); PG8_BAR; PG8_SCHED;
            PG8_LDB(B0, 1, 0); PG8_LDB(B1, 1, 1); PG8_SCHED; PG8_LDA(At, 1, 0); PG8_STAGE(PG8_SA(0, 1), a2 + hstep, voffA);
            PG8_WAIT_V(8); PG8_WAIT_L(0); PG8_BAR; PG8_MMA(0, 0, At, B0); PG8_MMA(0, 1, At, B1); PG8_BAR; PG8_SCHED;
            PG8_LDA(At, 1, 1); PG8_STAGE(PG8_SB(1, 0), b3, voffB); PG8_STAGE(PG8_SB(1, 1), b3 + hstep, voffB); PG8_STAGE(PG8_SA(1, 0), a3, voffA);
            PG8_WAIT_V(8); PG8_WAIT_L(0); PG8_BAR; PG8_MMA(1, 0, At, B0); PG8_MMA(1, 1, At, B1); PG8_BAR; PG8_SCHED;
            } else {
            PG8_LDB(B0, 0, 0); PG8_SCHED; PG8_LDA(At, 0, 0); PG8_STAGE(PG8_SA(1, 1), a1 + hstep, voffA);
            PG8_WAIT_L(8); PG8_BAR; PG8_WAIT_L(0); PG8_MMA(0, 0, At, B0); PG8_BAR; PG8_SCHED;
            PG8_LDB(B1, 0, 1); PG8_STAGE(PG8_SB(0, 0), b2, voffB);
            PG8_BAR; PG8_WAIT_L(0); PG8_MMA(0, 1, At, B1); PG8_BAR;
            PG8_LDA(At, 0, 1); PG8_STAGE(PG8_SA(0, 0), a2, voffA);
            PG8_BAR; PG8_WAIT_L(0); PG8_MMA(1, 0, At, B0); PG8_BAR; PG8_SCHED;
            PG8_STAGE(PG8_SB(0, 1), b2 + hstep, voffB);
            PG8_WAIT_V(6); PG8_BAR; PG8_MMA(1, 1, At, B1); PG8_BAR;
            PG8_LDB(B0, 1, 0); PG8_SCHED; PG8_LDA(At, 1, 0); PG8_STAGE(PG8_SA(0, 1), a2 + hstep, voffA);
            PG8_WAIT_L(8); PG8_BAR; PG8_WAIT_L(0); PG8_MMA(0, 0, At, B0); PG8_BAR; PG8_SCHED;
            PG8_LDB(B1, 1, 1); PG8_STAGE(PG8_SB(1, 0), b3, voffB);
            PG8_BAR; PG8_WAIT_L(0); PG8_MMA(0, 1, At, B1); PG8_BAR;
            PG8_LDA(At, 1, 1); PG8_STAGE(PG8_SA(1, 0), a3, voffA);
            PG8_BAR; PG8_WAIT_L(0); PG8_MMA(1, 0, At, B0); PG8_BAR; PG8_SCHED;
            PG8_STAGE(PG8_SB(1, 1), b3 + hstep, voffB);
            PG8_WAIT_V(6); PG8_BAR; PG8_MMA(1, 1, At, B1); PG8_BAR;
            }
        }
        if constexpr (ALIGN_EPI) { if (wr == 0) PG8_BAR; }
        if constexpr (!Epi::AFTER_DRAIN) { E(acc, cur, wr, wc, fr, fq); S.done(cur); }
        if (!has_next) break;
#pragma unroll
        for (int a = 0; a < 2; ++a)
#pragma unroll
            for (int b = 0; b < 2; ++b)
#pragma unroll
                for (int m = 0; m < 4; ++m)
#pragma unroll
                    for (int n = 0; n < 2; ++n) acc[a][b][m][n] = (f32x4){0.f, 0.f, 0.f, 0.f};
        cur = nxt; cA = nA; cB = nB; ++ui;
        if constexpr (ALIGN_EPI) { if (wr == 1) PG8_BAR; }
    }
    PG8_WAIT_V(0);
    if constexpr (!ALIGN_EPI) { if (wr == 0) PG8_BAR; }
    PG8_BAR;
    if constexpr (Epi::AFTER_DRAIN) { E.fused(acc, cur, wr, wc, fr, fq, lds, wid, lane); S.done(cur); }
#undef PG8_SA
#undef PG8_SB
#undef PG8_STAGE
#undef PG8_LDA
#undef PG8_LDB
#undef PG8_MMA
#undef PG8_WAIT_V
#undef PG8_WAIT_L
#undef PG8_BAR
#undef PG8_SCHED
}
}

#define LAS __attribute__((address_space(3)))
#define DEVINL __device__ __forceinline__
typedef _Float16 half_t;
typedef _Float16 h8 __attribute__((ext_vector_type(8)));
typedef _Float16 h4 __attribute__((ext_vector_type(4)));
typedef _Float16 h2 __attribute__((ext_vector_type(2)));
typedef float f32x4 __attribute__((ext_vector_type(4)));
typedef float f32x2 __attribute__((ext_vector_type(2)));

#ifndef PROBE_MASK
#define PROBE_MASK 0
#endif
#define REP(k) for (int rep_ = 0; rep_ < 1 + ((PROBE_MASK >> (k)) & 1); ++rep_)
constexpr int NWAVES = 8, NTHREADS = 512;
constexpr int D = 1024, TP = 2064, NBP = 8, NTP = NBP * TP, NBS = 128, TSS = 4, NTS = NBS * TSS, NT = NTP + NTS, MP = 17152;
static_assert(NTP == 16512 && NT == 17024 && MP % 256 == 0 && MP >= NT + NBS, "rows");
constexpr int LDZ_AB = 3584, LDZ_C = 4352, DFF = 2816, LDH = 2 * DFF;
constexpr int ZR = 1792;
constexpr float ALPHA = 1.6817928305074292f;
constexpr int NSEQ = NBP + NBS;

constexpr size_t O_YP = 0, O_YS = O_YP + (size_t)NBP * 2048 * D, O_PGLA = O_YS + (size_t)NTS * D, O_PRWKV = O_PGLA + (size_t)2 * 8 * 4 * 64 * 128,
    O_PSHIFT = O_PRWKV + (size_t)2 * 8 * 8 * 64 * 64, O_PGDN = O_PSHIFT + (size_t)2 * 8 * D, O_PGDNCONV = O_PGDN + (size_t)2 * 8 * 8 * 128 * 128,
    O_PFFNCONV = O_PGDNCONV + (size_t)2 * 8 * 3 * 3072, O_SGLA = O_PFFNCONV + (size_t)4 * 8 * 2 * DFF, O_SRWKV = O_SGLA + (size_t)2 * 128 * 4 * 64 * 128,
    O_SSHIFT = O_SRWKV + (size_t)2 * 128 * 8 * 64 * 64, O_SGDN = O_SSHIFT + (size_t)2 * 128 * D, O_SGDNCONV = O_SGDN + (size_t)2 * 128 * 8 * 128 * 128,
    O_SFFNCONV = O_SGDNCONV + (size_t)2 * 128 * 3 * 3072, O_END = O_SFFNCONV + (size_t)4 * 128 * 2 * DFF;
static_assert(O_END == 76627968, "output size");

constexpr size_t MiB = 1u << 20;
constexpr size_t WS_WIN = 1 * MiB, WS_WOUT = 10 * MiB, WS_WUP = 12 * MiB, WS_WDN = 23 * MiB;
constexpr size_t WS_W2T = 29 * MiB, WS_A2T = WS_W2T + 65536, WS_G2T = WS_A2T + 65536, WS_GW2T = WS_G2T + 131072;
constexpr size_t WS_X = 32 * MiB, WS_XB = 100 * MiB, WS_MO = 134 * MiB  , WS_FREE = 168 * MiB, WS_BIG = 227 * MiB;
constexpr size_t WS_GA = WS_FREE, WS_OG = WS_FREE + 17 * MiB, WS_YR = WS_FREE + 34 * MiB;
constexpr size_t WS_OD = WS_FREE;
constexpr size_t WS_Z = WS_BIG;
constexpr size_t WS_RPH = WS_BIG + 119 * MiB, WS_RPW = WS_BIG + 219 * MiB, WS_BON = WS_BIG + 253 * MiB;
constexpr size_t WS_GQ = WS_BIG + 143 * MiB, WS_GK = WS_GQ + 34 * MiB, WS_GV = WS_GK + 34 * MiB, WS_GS = WS_GV + 34 * MiB;
constexpr size_t WS_XACC = WS_BIG;
constexpr size_t WS_END = WS_BIG + 255 * MiB;
constexpr int SPLIT_ROW0 = 16384;
static_assert(WS_X + (size_t)MP * D * 4 <= WS_XB && WS_XB + (size_t)MP * D * 2 <= WS_MO && WS_MO + (size_t)MP * DFF * 2 <= WS_BIG && WS_MO + (size_t)MP * D * 2 <= WS_FREE, "ws map 1");
static_assert(WS_YR + (size_t)NT * 512 * 2 <= WS_BIG && WS_OD + (size_t)NT * 1024 * 2 <= WS_BIG && WS_GA + (size_t)NT * 256 * 4 <= WS_OG && WS_OG + (size_t)NT * 512 * 2 <= WS_YR, "ws map 2");
static_assert(WS_Z + (size_t)MP * LDZ_AB * 2 <= WS_RPH && WS_RPH + (size_t)NT * 6 * 512 * 2 <= WS_RPW && WS_RPW + (size_t)NT * 512 * 4 <= WS_BON && WS_BON + (size_t)NT * 8 * 4 <= WS_END, "ws map 3");
static_assert(WS_Z + (size_t)MP * LDZ_C * 2 <= WS_GQ && WS_GS + (size_t)NT * 32 * 4 <= WS_END && WS_Z + (size_t)MP * LDH * 2 <= WS_END, "ws map 4");
static_assert(WS_WIN + (size_t)LDZ_C * D * 2 <= WS_WOUT && WS_WOUT + (size_t)D * D * 2 <= WS_WUP && WS_WUP + (size_t)LDH * D * 2 <= WS_WDN && WS_WDN + (size_t)D * DFF * 2 <= WS_X, "ws map 5");

constexpr int LDS_BYTES = 147456;

struct Params { const float* in[39]; float* out; unsigned char* ws; int ph_lo, ph_hi; };

template <int CTRL> DEVINL float dpp_f(float v) { return __builtin_bit_cast(float, __builtin_amdgcn_update_dpp(0, __builtin_bit_cast(int, v), CTRL, 0xf, 0xf, false)); }
DEVINL float red16(float v) { v += dpp_f<0x128>(v); v += dpp_f<0x124>(v); v += dpp_f<0x122>(v); v += dpp_f<0x121>(v); return v; }
DEVINL float wave_sum(float v) {
    v = red16(v);
    v += __builtin_bit_cast(float, __builtin_amdgcn_update_dpp(0, __builtin_bit_cast(int, v), 0x142, 0xa, 0xf, false));
    v += __builtin_bit_cast(float, __builtin_amdgcn_update_dpp(0, __builtin_bit_cast(int, v), 0x143, 0xc, 0xf, false));
    return __builtin_bit_cast(float, __builtin_amdgcn_readlane(__builtin_bit_cast(int, v), 63));
}
DEVINL void bar_sync() { __builtin_amdgcn_fence(__ATOMIC_RELEASE, "workgroup"); __builtin_amdgcn_s_barrier(); __builtin_amdgcn_fence(__ATOMIC_ACQUIRE, "workgroup"); }
DEVINL float sigmoidf_(float x) { return 1.f / (1.f + __expf(-x)); }
DEVINL float siluf_(float x) { return x / (1.f + __expf(-x)); }
DEVINL f32x4 ld_h4(const half_t* p) { const h4 v = *(const h4*)p; return (f32x4){(float)v[0], (float)v[1], (float)v[2], (float)v[3]}; }
DEVINL void st_h4(half_t* p, f32x4 v) { h4 o; o[0] = (half_t)v[0]; o[1] = (half_t)v[1]; o[2] = (half_t)v[2]; o[3] = (half_t)v[3]; *(h4*)p = o; }
DEVINL void ld_h8f(const half_t* p, float (&o)[8]) { const h8 v = *(const h8*)p;
#pragma unroll
    for (int e = 0; e < 8; ++e) o[e] = (float)v[e]; }
DEVINL void ld_f8(const float* p, float (&o)[8]) { const f32x4 a = *(const f32x4*)p, b = *(const f32x4*)(p + 4); o[0] = a[0]; o[1] = a[1]; o[2] = a[2]; o[3] = a[3]; o[4] = b[0]; o[5] = b[1]; o[6] = b[2]; o[7] = b[3]; }
#define LDS_WAIT() asm volatile("s_waitcnt lgkmcnt(0)" ::: "memory")

DEVINL void row_info(int row, int& t, int& sb) { if (row < NTP) { t = row % TP; sb = -1; } else { const int r = row - NTP; t = r & 3; sb = r >> 2; } }

template <int MODE> DEVINL int src_col(int dst, int N) {
    if (MODE == 0) return dst < N ? dst : -1;
    if (dst < 1024) return dst;
    if (dst < 1536) return 1040 + (dst - 1024);
    if (dst < 1552) return 1024 + (dst - 1536);
    if (dst < ZR) return -1;
    return 1552 + (dst - ZR);
}
template <int MODE> DEVINL void convert_w(const float* __restrict__ W, int K, int N, int Npad, half_t* __restrict__ WT, LAS float* scr, int gw, int ngw, int lane) {
    const int nblk = Npad / 32, nitems = (K / 64) * nblk;
    for (int it = gw; it < nitems; it += ngw) {
        const int kb = it / nblk, nb = it - kb * nblk, k0 = 64 * kb, n0 = 32 * nb;
        const int sc = src_col<MODE>(n0 + (lane & 31), N);
#pragma unroll 8
        for (int i = 0; i < 32; ++i) { const int kk = 2 * i + (lane >> 5); scr[kk * 33 + (lane & 31)] = sc >= 0 ? W[(size_t)(k0 + kk) * N + sc] : 0.f; }
        LDS_WAIT();
        const int c = lane & 7;
#pragma unroll
        for (int j = 0; j < 4; ++j) { const int n = (lane >> 3) + 8 * j; const LAS float* s = scr + (8 * c) * 33 + n;
            h8 o;
#pragma unroll
            for (int e = 0; e < 8; ++e) o[e] = (half_t)s[e * 33];
            *(h8*)(WT + (size_t)(n0 + n) * K + k0 + 8 * c) = o; }
        LDS_WAIT();
    }
}
DEVINL void convert_layer_weights(const Params& P, int l, LAS unsigned char* lds, int gw, int ngw, int lane, int wave) {
    LAS float* scr = (LAS float*)(lds + wave * 16384);
    const int i = l >> 1;
    if ((l & 1) == 0) {
        convert_w<1>(P.in[9] + (size_t)i * D * 3344, D, 3344, LDZ_AB, (half_t*)(P.ws + WS_WIN), scr, gw, ngw, lane);
        convert_w<0>(P.in[24] + (size_t)i * D * D, D, D, D, (half_t*)(P.ws + WS_WOUT), scr, gw, ngw, lane);
        {
            half_t* W2T = (half_t*)(P.ws + WS_W2T); half_t* A2T = (half_t*)(P.ws + WS_A2T); half_t* G2T = (half_t*)(P.ws + WS_G2T); half_t* GW2T = (half_t*)(P.ws + WS_GW2T);
            const float* w2 = P.in[15] + (size_t)i * 64 * 512; const float* a2 = P.in[17] + (size_t)i * 64 * 512; const float* g2 = P.in[18] + (size_t)i * 128 * 512; const float* gw2 = P.in[10] + (size_t)i * 16 * 256;
            const int gt = gw * 64 + lane, ngt = ngw * 64;
            for (int idx = gt; idx < 512 * 64; idx += ngt) { const int col = idx >> 6, k = idx & 63; W2T[idx] = (half_t)w2[(size_t)k * 512 + col]; A2T[idx] = (half_t)a2[(size_t)k * 512 + col]; }
            for (int idx = gt; idx < 512 * 128; idx += ngt) { const int col = idx >> 7, k = idx & 127; G2T[idx] = (half_t)g2[(size_t)k * 512 + col]; }
            for (int idx = gt; idx < 256 * 32; idx += ngt) { const int col = idx >> 5, k = idx & 31; GW2T[idx] = k < 16 ? (half_t)gw2[k * 256 + col] : (half_t)0.f; }
        }
    } else {
        convert_w<0>(P.in[25] + (size_t)i * D * 4112, D, 4112, LDZ_C, (half_t*)(P.ws + WS_WIN), scr, gw, ngw, lane);
        convert_w<0>(P.in[30] + (size_t)i * D * D, D, D, D, (half_t*)(P.ws + WS_WOUT), scr, gw, ngw, lane);
    }
    convert_w<0>(P.in[31] + (size_t)l * D * LDH, D, LDH, LDH, (half_t*)(P.ws + WS_WUP), scr, gw, ngw, lane);
    convert_w<0>(P.in[34] + (size_t)l * DFF * D, DFF, D, D, (half_t*)(P.ws + WS_WDN), scr, gw, ngw, lane);
}

DEVINL void zero_xacc(const Params& P, int gw, int ngw, int lane) {
    f32x4* xa = (f32x4*)(P.ws + WS_XACC);
    for (int idx = gw * 64 + lane; idx < 768 * 1024 / 4; idx += ngw * 64) xa[idx] = (f32x4){0.f, 0.f, 0.f, 0.f};
}
DEVINL void phase_prologue(const Params& P, int gw, int ngw, int lane) {
    float* X = (float*)(P.ws + WS_X); half_t* XB = (half_t*)(P.ws + WS_XB);
    for (int row = gw; row < MP; row += ngw) {
        const float* src; float* sh = nullptr;
        if (row < NTP) { const int b = row / TP, t = row - b * TP; src = t < 16 ? P.in[8] + (size_t)t * D : P.in[0] + ((size_t)b * 2048 + (t - 16)) * D; if (t == TP - 1) sh = P.out + O_PSHIFT + (size_t)b * D; }
        else if (row < NT) { const int r = row - NTP; src = P.in[1] + (size_t)r * D; if ((r & 3) == 3) sh = P.out + O_SSHIFT + (size_t)(r >> 2) * D; }
        else if (row < NT + NBS) src = P.in[4] + (size_t)(row - NT) * D;
        else src = nullptr;
#pragma unroll
        for (int j = 0; j < 4; ++j) {
            const f32x4 v = src ? ((const f32x4*)src)[lane + 64 * j] : (f32x4){0.f, 0.f, 0.f, 0.f};
            if (row < NT) ((f32x4*)(X + (size_t)row * D))[lane + 64 * j] = v;
            st_h4(XB + (size_t)row * D + 4 * (lane + 64 * j), v);
            if (sh) ((f32x4*)sh)[lane + 64 * j] = v;
        }
    }
}

DEVINL void phase_ln(const Params& P, const float* __restrict__ g, const float* __restrict__ bta, bool final, int shift_i, int nsl, int gw, int ngw, int lane, bool dummy = false) {
    float* X = (float*)(P.ws + WS_X); half_t* XB = (half_t*)(P.ws + WS_XB);
    float* XO = dummy ? (float*)(P.ws + WS_Z) : X; half_t* XBO = dummy ? (half_t*)(P.ws + WS_Z + 80 * MiB) : XB;
    f32x4 gv[4], bv[4];
#pragma unroll
    for (int j = 0; j < 4; ++j) { gv[j] = ((const f32x4*)g)[lane + 64 * j]; bv[j] = ((const f32x4*)bta)[lane + 64 * j]; }
    for (int row = gw; row < NT; row += ngw) {
        f32x4* xr = (f32x4*)(X + (size_t)row * D);
        f32x4 v[4]; float s = 0.f;
#pragma unroll
        for (int j = 0; j < 4; ++j) { v[j] = xr[lane + 64 * j]; if (row >= SPLIT_ROW0) { f32x4 a = v[j] * ALPHA; for (int p = 0; p < nsl; ++p) a = a + ((const f32x4*)(P.ws + WS_XACC + ((size_t)p * 768 + (row - SPLIT_ROW0)) * D * 4))[lane + 64 * j]; v[j] = a; } s += (v[j][0] + v[j][1]) + (v[j][2] + v[j][3]); }
        const float mean = wave_sum(s) * (1.f / D); float s2 = 0.f;
#pragma unroll
        for (int j = 0; j < 4; ++j) { v[j] = v[j] - mean; s2 += (v[j][0] * v[j][0] + v[j][1] * v[j][1]) + (v[j][2] * v[j][2] + v[j][3] * v[j][3]); }
        const float rstd = rsqrtf(wave_sum(s2) * (1.f / D) + 1e-5f);
        int t, sb; row_info(row, t, sb);
        float* dst = nullptr; float* sh = nullptr;
        if (final) { if (sb >= 0) dst = P.out + O_YS + (size_t)(row - NTP) * D; else if (t >= 16) dst = P.out + O_YP + ((size_t)(row / TP) * 2048 + (t - 16)) * D; }
        if (shift_i >= 0) { if (sb >= 0) { if (t == 3) sh = P.out + O_SSHIFT + ((size_t)shift_i * NBS + sb) * D; } else if (t == TP - 1) sh = P.out + O_PSHIFT + ((size_t)shift_i * NBP + row / TP) * D; }
#pragma unroll
        for (int j = 0; j < 4; ++j) {
            const f32x4 y = v[j] * rstd * gv[j] + bv[j];
            if (final) { if (dst) ((f32x4*)dst)[lane + 64 * j] = y; }
            else { ((f32x4*)(XO + (size_t)row * D))[lane + 64 * j] = y; st_h4(XBO + (size_t)row * D + 4 * (lane + 64 * j), y); }
            if (sh) ((f32x4*)sh)[lane + 64 * j] = y;
        }
    }
    if (shift_i >= 0) {
        const float* st = P.in[4] + (size_t)shift_i * NBS * D;
        for (int b = gw; b < NBS; b += ngw)
#pragma unroll
            for (int j = 0; j < 4; ++j) st_h4(XB + (size_t)(NT + b) * D + 4 * (lane + 64 * j), ((const f32x4*)(st + (size_t)b * D))[lane + 64 * j]);
    }
}

DEVINL void phase_act(const Params& P, int l, int gw, int ngw, int lane) {
    const half_t* H = (const half_t*)(P.ws + WS_Z); half_t* A2 = (half_t*)(P.ws + WS_MO);
    const float* cw = P.in[32] + (size_t)l * 3 * DFF; const float* cb = P.in[33] + (size_t)l * DFF; const float* st = P.in[7] + (size_t)l * NBS * 2 * DFF;
    constexpr int NCG = 6, NRB = NT / 16;
    for (int it = gw; it < NRB * NCG; it += ngw) {
        const int rb = it / NCG, cgp = it - rb * NCG, c = cgp * 512 + lane * 8, r0 = rb * 16;
        if (c >= DFF) continue;
        float w0[8], w1[8], w2[8], bb[8], g1[8], g2[8];
        ld_f8(cw + c, w0); ld_f8(cw + DFF + c, w1); ld_f8(cw + 2 * DFF + c, w2); ld_f8(cb + c, bb);
        const bool prompt = r0 < NTP;
        if (prompt) {
            const int t0 = r0 % TP;
            if (t0 == 0) {
#pragma unroll
                for (int e = 0; e < 8; ++e) { g1[e] = 0.f; g2[e] = 0.f; } }
            else { ld_h8f(H + (size_t)(r0 - 1) * LDH + c, g1); ld_h8f(H + (size_t)(r0 - 2) * LDH + c, g2); }
        }
#pragma unroll 4
        for (int i = 0; i < 16; ++i) {
            const int row = r0 + i;
            if (!prompt && (i & 3) == 0) { const int sb = (row - NTP) >> 2; ld_f8(st + ((size_t)sb * 2 + 1) * DFF + c, g1); ld_f8(st + (size_t)sb * 2 * DFF + c, g2); }
            float g0[8], up[8]; ld_h8f(H + (size_t)row * LDH + c, g0); ld_h8f(H + (size_t)row * LDH + DFF + c, up);
            h8 o;
#pragma unroll
            for (int e = 0; e < 8; ++e) { const float x = w2[e] * g0[e] + w1[e] * g1[e] + w0[e] * g2[e] + bb[e]; o[e] = (half_t)(siluf_(x) * up[e]); g2[e] = g1[e]; g1[e] = g0[e]; }
            *(h8*)(A2 + (size_t)row * DFF + c) = o;
        }
    }
    for (int q = gw; q < NSEQ * 2; q += ngw) {
        const int s = q >> 1, j = q & 1;
        const int row = s < NBP ? s * TP + TP - 2 + j : NTP + (s - NBP) * 4 + 2 + j;
        float* dst = s < NBP ? P.out + O_PFFNCONV + (((size_t)l * NBP + s) * 2 + j) * DFF : P.out + O_SFFNCONV + (((size_t)l * NBS + (s - NBP)) * 2 + j) * DFF;
        for (int p = 0; p < 11; ++p) { const int c = p * 256 + lane * 4; *(f32x4*)(dst + c) = ld_h4(H + (size_t)row * LDH + c); }
    }
}

DEVINL const half_t* zprev_row(const half_t* Z, int row, int ldz) {
    if (row < NTP) return (row % TP) == 0 ? nullptr : Z + (size_t)(row - 1) * ldz;
    const int r = row - NTP; return (r & 3) == 0 ? Z + (size_t)(NT + (r >> 2)) * ldz : Z + (size_t)(row - 1) * ldz;
}
DEVINL void phase_prep_ab(const Params& P, int i, LAS unsigned char* lds, int tid, int lane, int wave, int G) {
    const half_t* Z = (const half_t*)(P.ws + WS_Z);
    half_t* RPH = (half_t*)(P.ws + WS_RPH); float* RPW = (float*)(P.ws + WS_RPW); float* BON = (float*)(P.ws + WS_BON); float* GA = (float*)(P.ws + WS_GA);
    const half_t* W2T = (const half_t*)(P.ws + WS_W2T); const half_t* A2T = (const half_t*)(P.ws + WS_A2T); const half_t* G2T = (const half_t*)(P.ws + WS_G2T); const half_t* GW2T = (const half_t*)(P.ws + WS_GW2T);
    const float* mu = P.in[13] + (size_t)i * 1792; const float* w0 = P.in[14] + i * 512; const float* a0 = P.in[16] + i * 512;
    const float* k_k = P.in[19] + i * 512; const float* k_a = P.in[20] + i * 512; const float* r_k = P.in[21] + i * 512; const float* gb = P.in[11] + i * 256;
    constexpr int XS = 264, GS_ = 40;
    LAS half_t* XL = (LAS half_t*)lds;
    LAS half_t* XG = XL + 16 * XS;
    const int tok0 = lane & 15, cg0 = lane >> 4, h = wave;
    for (int tile = blockIdx.x; tile < NT / 16; tile += G) {
        const int r0 = tile * 16;
        int tok = tok0, cg = cg0; asm volatile("" : "+v"(tok), "+v"(cg));
        {
            const int t2 = tid >> 5, c8 = (tid & 31) * 8, row = r0 + t2;
            const half_t* zc = Z + (size_t)row * LDZ_AB + ZR + 1536 + c8; const half_t* zp = zprev_row(Z, row, LDZ_AB);
            float cur[8], prv[8], m[8]; ld_h8f(zc, cur); ld_f8(mu + 1536 + c8, m);
            if (zp) ld_h8f(zp + ZR + 1536 + c8, prv); else {
#pragma unroll
                for (int e = 0; e < 8; ++e) prv[e] = 0.f; }
            h8 o;
#pragma unroll
            for (int e = 0; e < 8; ++e) { float v = cur[e] + m[e] * (prv[e] - cur[e]); if (c8 < 64) v = tanhf(v); else if (c8 >= 128) v = sigmoidf_(v); o[e] = (half_t)v; }
            *(LAS h8*)(XL + t2 * XS + c8) = o;
            if (tid < 64) { const int t3 = tid >> 2, q = tid & 3; h8 gq = {};
                if (q < 2) gq = *(const h8*)(Z + (size_t)(r0 + t3) * LDZ_AB + 1536 + q * 8);
                *(LAS h8*)(XG + t3 * GS_ + q * 8) = gq; }
        }
        bar_sync();
        {   const int row = r0 + tok;
            const half_t* zc = Z + (size_t)row * LDZ_AB + ZR; const half_t* zp = zprev_row(Z, row, LDZ_AB);
            half_t* rp = RPH + (size_t)row * 3072;
            float ss = 0.f, bon = 0.f; f32x4 kkr[4], alr[4];
            h8 bx[8];
#pragma unroll
            for (int s = 0; s < 8; ++s) bx[s] = *(const LAS h8*)(XL + tok * XS + s * 32 + 8 * cg);
#pragma unroll
            for (int f = 0; f < 4; ++f) {
                f32x4 aw = {0.f, 0.f, 0.f, 0.f}, aa = aw, ag = aw;
                const int wc = h * 64 + f * 16 + tok;
#pragma unroll
                for (int s = 0; s < 2; ++s) { const h8 wa = *(const h8*)(W2T + (size_t)wc * 64 + s * 32 + 8 * cg); aw = __builtin_amdgcn_mfma_f32_16x16x32_f16(wa, bx[s], aw, 0, 0, 0); }
#pragma unroll
                for (int s = 0; s < 2; ++s) { const h8 wa = *(const h8*)(A2T + (size_t)wc * 64 + s * 32 + 8 * cg); aa = __builtin_amdgcn_mfma_f32_16x16x32_f16(wa, bx[2 + s], aa, 0, 0, 0); }
#pragma unroll
                for (int s = 0; s < 4; ++s) { const h8 wa = *(const h8*)(G2T + (size_t)wc * 128 + s * 32 + 8 * cg); ag = __builtin_amdgcn_mfma_f32_16x16x32_f16(wa, bx[4 + s], ag, 0, 0, 0); }
                const int c = h * 64 + f * 16 + cg * 4;
                f32x4 pr = {0.f, 0.f, 0.f, 0.f}, pk = pr, pv = pr;
                const f32x4 cr = ld_h4(zc + c), ck = ld_h4(zc + 512 + c), cv = ld_h4(zc + 1024 + c);
                if (zp) { pr = ld_h4(zp + ZR + c); pk = ld_h4(zp + ZR + 512 + c); pv = ld_h4(zp + ZR + 1024 + c); }
                const f32x4 r = cr + *(const f32x4*)(mu + c) * (pr - cr), kr = ck + *(const f32x4*)(mu + 512 + c) * (pk - ck), vr = cv + *(const f32x4*)(mu + 1024 + c) * (pv - cv);
                const f32x4 wr = aw + *(const f32x4*)(w0 + c), ar = aa + *(const f32x4*)(a0 + c);
                f32x4 dec, al;
#pragma unroll
                for (int e = 0; e < 4; ++e) { dec[e] = __expf(-0.6065306597126334f * sigmoidf_(wr[e])); al[e] = sigmoidf_(ar[e]); }
                const f32x4 kk0 = kr * *(const f32x4*)(k_k + c);
                const f32x4 kmod = kr * ((al - 1.f) * *(const f32x4*)(k_a + c) + 1.f);
                const f32x4 bt = r * kmod * *(const f32x4*)(r_k + c);
                ss += (kk0[0] * kk0[0] + kk0[1] * kk0[1]) + (kk0[2] * kk0[2] + kk0[3] * kk0[3]); bon += (bt[0] + bt[1]) + (bt[2] + bt[3]);
                kkr[f] = kk0; alr[f] = al;
                st_h4(rp + c, r); st_h4(rp + 512 + c, kmod); st_h4(rp + 1024 + c, vr); st_h4(rp + 2560 + c, ag);
                *(f32x4*)(RPW + (size_t)row * 512 + c) = dec;
                asm volatile("" ::: "memory");
            }
            ss += __shfl_xor(ss, 16); ss += __shfl_xor(ss, 32); bon += __shfl_xor(bon, 16); bon += __shfl_xor(bon, 32);
            const float inv = rsqrtf(ss + 1e-6f);
#pragma unroll
            for (int f = 0; f < 4; ++f) { const int c = h * 64 + f * 16 + cg * 4; const f32x4 kk = kkr[f] * inv; st_h4(rp + 1536 + c, kk); st_h4(rp + 2048 + c, kk * alr[f]); }
            if (cg == 0) BON[(size_t)row * 8 + h] = bon;
            const h8 bg = *(const LAS h8*)(XG + tok * GS_ + 8 * cg);
#pragma unroll
            for (int q = 0; q < 2; ++q) {
                const int nf = wave * 2 + q;
                const h8 wa = *(const h8*)(GW2T + (size_t)(nf * 16 + tok) * 32 + 8 * cg);
                f32x4 x = __builtin_amdgcn_mfma_f32_16x16x32_f16(wa, bg, (f32x4){0.f, 0.f, 0.f, 0.f}, 0, 0, 0);
                const int c = nf * 16 + cg * 4; x = x + *(const f32x4*)(gb + c);
                f32x4 a;
#pragma unroll
                for (int e = 0; e < 4; ++e) { const float ls = fminf(x[e], 0.f) - log1pf(__expf(-fabsf(x[e]))); a[e] = __expf(ls * 0.0625f); }
                *(f32x4*)(GA + (size_t)row * 256 + c) = a;
            }
        }
        bar_sync();
    }
}

struct GlaS { float S[4]; f32x4 a[4]; h4 k[4], q[4]; half_t v[4]; };
DEVINL void gla_s_load(const Params& P, int i, int x, int lane, int wave, GlaS& r) {
    const half_t* Z = (const half_t*)(P.ws + WS_Z); const float* GA = (const float*)(P.ws + WS_GA);
    const int sb = x >> 4, h = (x >> 2) & 3, g = x & 3, col = g * 32 + wave * 4 + (lane >> 4), ks = lane & 15, row0 = NTP + sb * 4;
    const float* s0 = P.in[2] + (((size_t)i * NBS + sb) * 4 + h) * 8192;
#pragma unroll
    for (int e = 0; e < 4; ++e) r.S[e] = s0[(size_t)(ks * 4 + e) * 128 + col];
    const half_t* zq = Z + (size_t)row0 * LDZ_AB + h * 64 + ks * 4;
#pragma unroll
    for (int u = 0; u < 4; ++u) { r.a[u] = *(const f32x4*)(GA + (size_t)(row0 + u) * 256 + h * 64 + ks * 4); r.q[u] = *(const h4*)(zq + (size_t)u * LDZ_AB); r.k[u] = *(const h4*)(zq + (size_t)u * LDZ_AB + 256);
        r.v[u] = Z[(size_t)(row0 + u) * LDZ_AB + 512 + h * 128 + col]; }
}
DEVINL void gla_s_run(const Params& P, int i, int x, int lane, int wave, GlaS& r) {
    half_t* OG = (half_t*)(P.ws + WS_OG);
    const int sb = x >> 4, h = (x >> 2) & 3, g = x & 3, col = g * 32 + wave * 4 + (lane >> 4), ks = lane & 15, row0 = NTP + sb * 4;
    float* sout = P.out + O_SGLA + (((size_t)i * NBS + sb) * 4 + h) * 8192;
#pragma unroll
    for (int u = 0; u < 4; ++u) {
        const float v = (float)r.v[u]; float o = 0.f;
#pragma unroll
        for (int e = 0; e < 4; ++e) { r.S[e] = r.S[e] * r.a[u][e] + (float)r.k[u][e] * v; o += r.S[e] * (float)r.q[u][e]; }
        o = red16(o);
        if (ks == 0) OG[(size_t)(row0 + u) * 512 + h * 128 + col] = (half_t)(o * 0.125f);
    }
#pragma unroll
    for (int e = 0; e < 4; ++e) sout[(size_t)(ks * 4 + e) * 128 + col] = r.S[e];
}
struct RwS { float S[4]; f32x4 w[4]; h4 r[4], k[4], kk[4], b[4]; half_t v[4]; };
DEVINL void rw_s_load(const Params& P, int i, int x, int lane, int wave, RwS& r) {
    const half_t* RPH = (const half_t*)(P.ws + WS_RPH); const float* RPW = (const float*)(P.ws + WS_RPW);
    const int sb = x >> 4, h = (x >> 1) & 7, rg = x & 1, rv = rg * 32 + wave * 4 + (lane >> 4), ks = lane & 15, row0 = NTP + sb * 4;
    const float* s0 = P.in[3] + (((size_t)i * NBS + sb) * 8 + h) * 4096;
    const f32x4 sv = *(const f32x4*)(s0 + (size_t)rv * 64 + ks * 4);
    r.S[0] = sv[0]; r.S[1] = sv[1]; r.S[2] = sv[2]; r.S[3] = sv[3];
#pragma unroll
    for (int u = 0; u < 4; ++u) { const half_t* rp = RPH + (size_t)(row0 + u) * 3072 + h * 64 + ks * 4;
        r.w[u] = *(const f32x4*)(RPW + (size_t)(row0 + u) * 512 + h * 64 + ks * 4); r.r[u] = *(const h4*)rp; r.k[u] = *(const h4*)(rp + 512); r.kk[u] = *(const h4*)(rp + 1536); r.b[u] = *(const h4*)(rp + 2048);
        r.v[u] = RPH[(size_t)(row0 + u) * 3072 + 1024 + h * 64 + rv]; }
}
DEVINL void rw_s_run(const Params& P, int i, int x, int lane, int wave, RwS& r) {
    half_t* YR = (half_t*)(P.ws + WS_YR);
    const int sb = x >> 4, h = (x >> 1) & 7, rg = x & 1, rv = rg * 32 + wave * 4 + (lane >> 4), ks = lane & 15, row0 = NTP + sb * 4;
    float* sout = P.out + O_SRWKV + (((size_t)i * NBS + sb) * 8 + h) * 4096;
#pragma unroll
    for (int u = 0; u < 4; ++u) {
        float sa = 0.f;
#pragma unroll
        for (int e = 0; e < 4; ++e) sa -= r.S[e] * (float)r.kk[u][e];
        sa = red16(sa);
        const float v = (float)r.v[u]; float y = 0.f;
#pragma unroll
        for (int e = 0; e < 4; ++e) { r.S[e] = r.S[e] * r.w[u][e] + sa * (float)r.b[u][e] + v * (float)r.k[u][e]; y += r.S[e] * (float)r.r[u][e]; }
        y = red16(y);
        if (ks == 0) YR[(size_t)(row0 + u) * 512 + h * 64 + rv] = (half_t)y;
    }
    *(f32x4*)(sout + (size_t)rv * 64 + ks * 4) = (f32x4){r.S[0], r.S[1], r.S[2], r.S[3]};
}

constexpr int SC = 32;
DEVINL void gla_item_lds(const Params& P, LAS unsigned char* lds, int row0, int T, int h, int g, float* sout, int tid, int lane, int wave) {
    constexpr int TOKB = 576, BUFB = SC * TOKB, OB = 2 * BUFB, OBB = SC * 32 * 2 + 1024;
    const half_t* Z = (const half_t*)(P.ws + WS_Z); const float* GA = (const float*)(P.ws + WS_GA); half_t* OG = (half_t*)(P.ws + WS_OG);
    const int cl = wave * 4 + (lane >> 4), col = g * 32 + cl, ks = lane & 15;
    float S[4] = {0.f, 0.f, 0.f, 0.f}; const int dmy = SC * 32 + tid;
    const int a_tok = tid >> 4, a_c4 = (tid & 15) * 4, kq_sel = tid >> 8, kq_tok = (tid & 255) >> 3, kq_c8 = (tid & 7) * 8, v_tok = (tid & 127) >> 2, v_c8 = (tid & 3) * 8;
    const float* ga = GA + (size_t)(row0 + a_tok) * 256 + h * 64 + a_c4;
    const half_t* zkq = Z + (size_t)(row0 + kq_tok) * LDZ_AB + (kq_sel ? 0 : 256) + h * 64 + kq_c8;
    const half_t* zv = Z + (size_t)(row0 + v_tok) * LDZ_AB + 512 + h * 128 + g * 32 + v_c8;
    const int a_off = a_tok * TOKB + a_c4 * 4, kq_off = kq_tok * TOKB + 256 + kq_sel * 128 + kq_c8 * 2, v_off = v_tok * TOKB + 512 + v_c8 * 2;
    f32x4 ra = {0.f, 0.f, 0.f, 0.f}; h8 rkq = {}, rv = {};
#define GLA_LOAD(t0) do { if ((t0) + a_tok < T) ra = *(const f32x4*)(ga + (size_t)(t0) * 256); if ((t0) + kq_tok < T) rkq = *(const h8*)(zkq + (size_t)(t0) * LDZ_AB); \
        if (tid < 128 && (t0) + v_tok < T) rv = *(const h8*)(zv + (size_t)(t0) * LDZ_AB); } while (0)
#define GLA_STORE(bi) do { LAS unsigned char* b_ = lds + (bi) * BUFB; *(LAS f32x4*)(b_ + a_off) = ra; *(LAS h8*)(b_ + kq_off) = rkq; if (tid < 128) *(LAS h8*)(b_ + v_off) = rv; } while (0)
    GLA_LOAD(0); GLA_STORE(0); bar_sync();
    int c = 0;
    for (int t0 = 0; t0 < T; t0 += SC, ++c) {
        const bool more = t0 + SC < T; if (more) GLA_LOAD(t0 + SC);
        const int n = (T - t0) < SC ? (T - t0) : SC;
        const LAS unsigned char* base = lds + (c & 1) * BUFB; LAS half_t* ob = (LAS half_t*)(lds + OB + (c & 1) * OBB);
#define GLA_OP(A, K, Q, V, tt) do { const LAS unsigned char* tb_ = base + (tt) * TOKB; A = *(const LAS f32x4*)(tb_ + ks * 16); K = *(const LAS h4*)(tb_ + 256 + ks * 8); Q = *(const LAS h4*)(tb_ + 384 + ks * 8); V = *(const LAS half_t*)(tb_ + 512 + cl * 2); } while (0)
#define GLA_STEP(A, K, Q, V, tt) do { const float v_ = (float)V; float o_ = 0.f; _Pragma("unroll") for (int e = 0; e < 4; ++e) { S[e] = S[e] * A[e] + (float)K[e] * v_; o_ += S[e] * (float)Q[e]; } \
        o_ = red16(o_); ob[ks == 0 ? (tt) * 32 + cl : dmy] = (half_t)(o_ * 0.125f); } while (0)
        {   f32x4 a0, a1; h4 k0, k1, q0, q1; half_t v0, v1;
            GLA_OP(a0, k0, q0, v0, 0);
            for (int t = 0; t < n; t += 2) { GLA_OP(a1, k1, q1, v1, t + 1); GLA_STEP(a0, k0, q0, v0, t); GLA_OP(a0, k0, q0, v0, t + 2); GLA_STEP(a1, k1, q1, v1, t + 1); }
        }
#undef GLA_OP
#undef GLA_STEP
        if (more) GLA_STORE((c + 1) & 1);
        bar_sync();
        if (tid < 128 && v_tok < n) *(h8*)(OG + (size_t)(row0 + t0 + v_tok) * 512 + h * 128 + g * 32 + v_c8) = *(const LAS h8*)(ob + v_tok * 32 + v_c8);
    }
#undef GLA_LOAD
#undef GLA_STORE
#pragma unroll
    for (int e = 0; e < 4; ++e) sout[(size_t)(ks * 4 + e) * 128 + col] = S[e];
    bar_sync();
}
DEVINL void rwkv_item_lds(const Params& P, LAS unsigned char* lds, int row0, int T, int h, int rg, float* sout, int tid, int lane, int wave) {
    constexpr int TOKB = 832, BUFB = SC * TOKB, OB = 2 * BUFB, OBB = SC * 32 * 2 + 1024;
    const half_t* RPH = (const half_t*)(P.ws + WS_RPH); const float* RPW = (const float*)(P.ws + WS_RPW); half_t* YR = (half_t*)(P.ws + WS_YR);
    const int rl = wave * 4 + (lane >> 4), rv_ = rg * 32 + rl, ks = lane & 15;
    float S[4] = {0.f, 0.f, 0.f, 0.f}; const int dmy = SC * 32 + tid;
    const int w_tok = tid >> 4, w_c4 = (tid & 15) * 4, x_sel = tid >> 8, x_tok = (tid & 255) >> 3, x_c8 = (tid & 7) * 8, v_tok = (tid & 127) >> 2, v_c8 = (tid & 3) * 8;
    const float* wp = RPW + (size_t)(row0 + w_tok) * 512 + h * 64 + w_c4;
    const half_t* xp0 = RPH + (size_t)(row0 + x_tok) * 3072 + (x_sel ? 1536 : 0) + h * 64 + x_c8;
    const half_t* xp1 = RPH + (size_t)(row0 + x_tok) * 3072 + (x_sel ? 2048 : 512) + h * 64 + x_c8;
    const half_t* vp = RPH + (size_t)(row0 + v_tok) * 3072 + 1024 + h * 64 + rg * 32 + v_c8;
    const int w_off = w_tok * TOKB + w_c4 * 4, x_off0 = x_tok * TOKB + 256 + (x_sel ? 256 : 0) + x_c8 * 2, x_off1 = x_off0 + 128, v_off = v_tok * TOKB + 768 + v_c8 * 2;
    f32x4 rw = {0.f, 0.f, 0.f, 0.f}; h8 rx0 = {}, rx1 = {}, rvv = {};
#define RW_LOAD(t0) do { if ((t0) + w_tok < T) rw = *(const f32x4*)(wp + (size_t)(t0) * 512); if ((t0) + x_tok < T) { rx0 = *(const h8*)(xp0 + (size_t)(t0) * 3072); rx1 = *(const h8*)(xp1 + (size_t)(t0) * 3072); } \
        if (tid < 128 && (t0) + v_tok < T) rvv = *(const h8*)(vp + (size_t)(t0) * 3072); } while (0)
#define RW_STORE(bi) do { LAS unsigned char* b_ = lds + (bi) * BUFB; *(LAS f32x4*)(b_ + w_off) = rw; *(LAS h8*)(b_ + x_off0) = rx0; *(LAS h8*)(b_ + x_off1) = rx1; if (tid < 128) *(LAS h8*)(b_ + v_off) = rvv; } while (0)
    RW_LOAD(0); RW_STORE(0); bar_sync();
    int c = 0;
    for (int t0 = 0; t0 < T; t0 += SC, ++c) {
        const bool more = t0 + SC < T; if (more) RW_LOAD(t0 + SC);
        const int n = (T - t0) < SC ? (T - t0) : SC;
        const LAS unsigned char* base = lds + (c & 1) * BUFB; LAS half_t* ob = (LAS half_t*)(lds + OB + (c & 1) * OBB);
#define RW_OP(W, R, K, KK, B, V, tt) do { const LAS unsigned char* tb_ = base + (tt) * TOKB; W = *(const LAS f32x4*)(tb_ + ks * 16); R = *(const LAS h4*)(tb_ + 256 + ks * 8); K = *(const LAS h4*)(tb_ + 384 + ks * 8); \
        KK = *(const LAS h4*)(tb_ + 512 + ks * 8); B = *(const LAS h4*)(tb_ + 640 + ks * 8); V = *(const LAS half_t*)(tb_ + 768 + rl * 2); } while (0)
#define RW_STEP(W, R, K, KK, B, V, tt) do { float sa_ = 0.f; _Pragma("unroll") for (int e = 0; e < 4; ++e) sa_ -= S[e] * (float)KK[e]; sa_ = red16(sa_); const float v_ = (float)V; float y_ = 0.f; \
        _Pragma("unroll") for (int e = 0; e < 4; ++e) { S[e] = S[e] * W[e] + sa_ * (float)B[e] + v_ * (float)K[e]; y_ += S[e] * (float)R[e]; } \
        y_ = red16(y_); ob[ks == 0 ? (tt) * 32 + rl : dmy] = (half_t)y_; } while (0)
        {   f32x4 w0, w1; h4 r0, r1, k0, k1, kk0, kk1, b0, b1; half_t v0, v1;
            RW_OP(w0, r0, k0, kk0, b0, v0, 0);
            for (int t = 0; t < n; t += 2) { RW_OP(w1, r1, k1, kk1, b1, v1, t + 1); RW_STEP(w0, r0, k0, kk0, b0, v0, t); RW_OP(w0, r0, k0, kk0, b0, v0, t + 2); RW_STEP(w1, r1, k1, kk1, b1, v1, t + 1); }
        }
#undef RW_OP
#undef RW_STEP
        if (more) RW_STORE((c + 1) & 1);
        bar_sync();
        if (tid < 128 && v_tok < n) *(h8*)(YR + (size_t)(row0 + t0 + v_tok) * 512 + h * 64 + rg * 32 + v_c8) = *(const LAS h8*)(ob + v_tok * 32 + v_c8);
    }
#undef RW_LOAD
#undef RW_STORE
#pragma unroll
    for (int e = 0; e < 4; ++e) sout[(size_t)rv_ * 64 + ks * 4 + e] = S[e];
    bar_sync();
}
DEVINL void gdn_item_lds(const Params& P, LAS unsigned char* lds, int row0, int T, int h, int g, float* sout, int tid, int lane, int wave) {
    constexpr int TOKF = 292, BUFF = SC * TOKF, OB = 2 * BUFF * 4, OBB = SC * 32 * 2 + 1024;
    const half_t* GQ = (const half_t*)(P.ws + WS_GQ); const half_t* GK = (const half_t*)(P.ws + WS_GK); const half_t* GV = (const half_t*)(P.ws + WS_GV); const float* GS = (const float*)(P.ws + WS_GS);
    half_t* OD = (half_t*)(P.ws + WS_OD);
    LAS float* lf = (LAS float*)lds;
    const int cl = wave * 4 + (lane >> 4), col = g * 32 + cl, ks = lane & 15;
    f32x2 S2[4]; const int dmy = SC * 32 + tid;
#pragma unroll
    for (int e = 0; e < 4; ++e) S2[e] = (f32x2){0.f, 0.f};
    const int s_tok = tid >> 4, s_ks = tid & 15, v_tok = (tid & 127) >> 2, v_c8 = (tid & 3) * 8, c_tok = (tid - 128) & 31;
    const half_t* kp = GK + (size_t)(row0 + s_tok) * 1024 + h * 128 + s_ks * 8; const half_t* qp = GQ + (size_t)(row0 + s_tok) * 1024 + h * 128 + s_ks * 8;
    const half_t* vp = GV + (size_t)(row0 + v_tok) * 1024 + h * 128 + g * 32 + v_c8;
    const float* sp = GS + ((size_t)(row0 + c_tok) * 8 + h) * 4;
    const bool is_v = tid < 128, is_c = tid >= 128 && tid < 160;
    h8 rk = {}, rq = {}, rv = {}; f32x4 rs = {0.f, 0.f, 0.f, 0.f};
#define GD_LOAD(t0) do { if ((t0) + s_tok < T) { rk = *(const h8*)(kp + (size_t)(t0) * 1024); rq = *(const h8*)(qp + (size_t)(t0) * 1024); } \
        if (is_v && (t0) + v_tok < T) rv = *(const h8*)(vp + (size_t)(t0) * 1024); if (is_c && (t0) + c_tok < T) rs = *(const f32x4*)(sp + (size_t)(t0) * 32); } while (0)
#define GD_STORE(bi) do { LAS float* b_ = lf + (bi) * BUFF; LAS float* tk = b_ + s_tok * TOKF + s_ks * 4; \
        *(LAS f32x4*)(tk) = (f32x4){(float)rk[0], (float)rk[1], (float)rk[2], (float)rk[3]}; *(LAS f32x4*)(tk + 64) = (f32x4){(float)rk[4], (float)rk[5], (float)rk[6], (float)rk[7]}; \
        *(LAS f32x4*)(tk + 128) = (f32x4){(float)rq[0], (float)rq[1], (float)rq[2], (float)rq[3]}; *(LAS f32x4*)(tk + 192) = (f32x4){(float)rq[4], (float)rq[5], (float)rq[6], (float)rq[7]}; \
        if (is_v) { LAS float* tv = b_ + v_tok * TOKF + 256 + v_c8; *(LAS f32x4*)(tv) = (f32x4){(float)rv[0], (float)rv[1], (float)rv[2], (float)rv[3]}; *(LAS f32x4*)(tv + 4) = (f32x4){(float)rv[4], (float)rv[5], (float)rv[6], (float)rv[7]}; } \
        if (is_c) *(LAS f32x4*)(b_ + c_tok * TOKF + 288) = rs; } while (0)
    GD_LOAD(0); GD_STORE(0); bar_sync();
    int c = 0;
    for (int t0 = 0; t0 < T; t0 += SC, ++c) {
        const bool more = t0 + SC < T; if (more) GD_LOAD(t0 + SC);
        const int n = (T - t0) < SC ? (T - t0) : SC;
        const LAS float* base = lf + (c & 1) * BUFF; LAS half_t* ob = (LAS half_t*)(lds + OB + (c & 1) * OBB);
#define GD_OP(K0, K1, Q0, Q1, V, SCL, tt) do { const LAS float* tb_ = base + (tt) * TOKF; K0 = *(const LAS f32x4*)(tb_ + ks * 4); K1 = *(const LAS f32x4*)(tb_ + 64 + ks * 4); Q0 = *(const LAS f32x4*)(tb_ + 128 + ks * 4); \
        Q1 = *(const LAS f32x4*)(tb_ + 192 + ks * 4); V = tb_[256 + cl]; SCL = *(const LAS f32x4*)(tb_ + 288); } while (0)
#define GD_STEP(K0, K1, Q0, Q1, V, SCL, tt) do { const f32x2 ka = {K0[0], K0[1]}, kb = {K0[2], K0[3]}, kc = {K1[0], K1[1]}, kd = {K1[2], K1[3]}; \
        const f32x2 qa = {Q0[0], Q0[1]}, qb = {Q0[2], Q0[3]}, qc = {Q1[0], Q1[1]}, qd = {Q1[2], Q1[3]}; \
        f32x2 p1 = S2[0] * ka; p1 = S2[1] * kb + p1; p1 = S2[2] * kc + p1; p1 = S2[3] * kd + p1; \
        f32x2 p2 = S2[0] * qa; p2 = S2[1] * qb + p2; p2 = S2[2] * qc + p2; p2 = S2[3] * qd + p2; \
        const float d1 = red16(p1[0] + p1[1]), d2 = red16(p2[0] + p2[1]); \
        const float beta = SCL[0], eg = SCL[1], qk = SCL[2]; const float uu = beta * (V - eg * d1); const f32x2 eg2 = {eg, eg}, uu2 = {uu, uu}; \
        S2[0] = S2[0] * eg2 + ka * uu2; S2[1] = S2[1] * eg2 + kb * uu2; S2[2] = S2[2] * eg2 + kc * uu2; S2[3] = S2[3] * eg2 + kd * uu2; \
        ob[ks == 0 ? (tt) * 32 + cl : dmy] = (half_t)(eg * d2 + qk * uu); } while (0)
        {   f32x4 ka0, kb0, qa0, qb0, sc0, ka1, kb1, qa1, qb1, sc1; float v0, v1;
            GD_OP(ka0, kb0, qa0, qb0, v0, sc0, 0);
            for (int t = 0; t < n; t += 2) { GD_OP(ka1, kb1, qa1, qb1, v1, sc1, t + 1); GD_STEP(ka0, kb0, qa0, qb0, v0, sc0, t); GD_OP(ka0, kb0, qa0, qb0, v0, sc0, t + 2); GD_STEP(ka1, kb1, qa1, qb1, v1, sc1, t + 1); }
        }
#undef GD_OP
#undef GD_STEP
        if (more) GD_STORE((c + 1) & 1);
        bar_sync();
        if (is_v && v_tok < n) *(h8*)(OD + (size_t)(row0 + t0 + v_tok) * 1024 + h * 128 + g * 32 + v_c8) = *(const LAS h8*)(ob + v_tok * 32 + v_c8);
    }
#undef GD_LOAD
#undef GD_STORE
#pragma unroll
    for (int e = 0; e < 4; ++e) { sout[(size_t)(ks * 8 + 2 * e) * 128 + col] = S2[e][0]; sout[(size_t)(ks * 8 + 2 * e + 1) * 128 + col] = S2[e][1]; }
    bar_sync();
}
#define SAMPLE_LOOP(TYPE, LOADF, RUNF, NITEMS) do { int x_ = blockIdx.x; if (x_ < (NITEMS)) { TYPE a_; LOADF(P, i, x_, lane, wave, a_); \
        for (;;) { const int xn_ = x_ + G; const bool more_ = xn_ < (NITEMS); TYPE b_; if (more_) LOADF(P, i, xn_, lane, wave, b_); RUNF(P, i, x_, lane, wave, a_); if (!more_) break; a_ = b_; x_ = xn_; } } } while (0)
DEVINL void phase_scan_ab(const Params& P, int i, LAS unsigned char* lds, int tid, int lane, int wave, int G) {
    REP(10) for (int it = blockIdx.x; it < 256; it += G) {
        if (it < 128) { const int b = it >> 4, h = (it >> 2) & 3, g = it & 3;
            gla_item_lds(P, lds, b * TP, TP, h, g, P.out + O_PGLA + (((size_t)i * NBP + b) * 4 + h) * 8192, tid, lane, wave);
        } else { const int x = it - 128, b = x >> 4, h = (x >> 1) & 7, rg = x & 1;
            rwkv_item_lds(P, lds, b * TP, TP, h, rg, P.out + O_PRWKV + (((size_t)i * NBP + b) * 8 + h) * 4096, tid, lane, wave);
        }
    }
    REP(11) { SAMPLE_LOOP(GlaS, gla_s_load, gla_s_run, 2048);
    SAMPLE_LOOP(RwS, rw_s_load, rw_s_run, 2048); }
}
DEVINL void phase_post_ab(const Params& P, int i, int gw, int ngw, int lane) {
    const half_t* Z = (const half_t*)(P.ws + WS_Z); const half_t* OG = (const half_t*)(P.ws + WS_OG); const half_t* YR = (const half_t*)(P.ws + WS_YR);
    const half_t* RPH = (const half_t*)(P.ws + WS_RPH); const float* BON = (const float*)(P.ws + WS_BON); half_t* MO = (half_t*)(P.ws + WS_MO);
    const float* ng = P.in[12] + i * 512; const float* lg = P.in[22] + i * 512; const float* lb = P.in[23] + i * 512;
    for (int row = gw; row < NT; row += ngw) {
#pragma unroll
        for (int h = 0; h < 4; ++h) {
            const int c = h * 128 + lane * 2;
            const h2 o = *(const h2*)(OG + (size_t)row * 512 + c); const float o0 = (float)o[0], o1 = (float)o[1];
            const float rs = rsqrtf(wave_sum(o0 * o0 + o1 * o1) * (1.f / 128.f) + 1e-6f);
            const h2 og = *(const h2*)(Z + (size_t)row * LDZ_AB + 1024 + c);
            h2 r; r[0] = (half_t)(o0 * rs * ng[c] * siluf_((float)og[0])); r[1] = (half_t)(o1 * rs * ng[c + 1] * siluf_((float)og[1]));
            *(h2*)(MO + (size_t)row * D + c) = r;
        }
#pragma unroll
        for (int h = 0; h < 8; ++h) {
            const int c = h * 64 + lane;
            const float y = (float)YR[(size_t)row * 512 + c];
            const float m = wave_sum(y) * (1.f / 64.f); const float d = y - m; const float var = wave_sum(d * d) * (1.f / 64.f);
            const float yn = d * rsqrtf(var + 64e-5f) * lg[c] + lb[c];
            const float v = (float)RPH[(size_t)row * 3072 + 1024 + c], gate = (float)RPH[(size_t)row * 3072 + 2560 + c];
            MO[(size_t)row * D + 512 + c] = (half_t)((yn + BON[(size_t)row * 8 + h] * v) * gate);
        }
    }
}

DEVINL void gdn_conv8(const half_t* zr, const float* cw, const float* cst, int t, int sb, int c, float (&o)[8]) {
    float x[8], w[8];
    ld_h8f(zr + c, x); ld_f8(cw + (size_t)3 * 3072 + c, w);
#pragma unroll
    for (int e = 0; e < 8; ++e) o[e] = w[e] * x[e];
#pragma unroll
    for (int d = 1; d < 4; ++d) {
        bool have = true;
        if (t >= d) ld_h8f(zr - (size_t)d * LDZ_C + c, x);
        else if (sb >= 0) ld_f8(cst + ((size_t)sb * 3 + (3 + t - d)) * 3072 + c, x);
        else have = false;
        if (have) { ld_f8(cw + (size_t)(3 - d) * 3072 + c, w);
#pragma unroll
            for (int e = 0; e < 8; ++e) o[e] += w[e] * x[e]; }
    }
#pragma unroll
    for (int e = 0; e < 8; ++e) o[e] = siluf_(o[e]);
}
DEVINL void phase_prep_c(const Params& P, int i, int gw, int ngw, int lane) {
    const half_t* Z = (const half_t*)(P.ws + WS_Z);
    half_t* GQ = (half_t*)(P.ws + WS_GQ); half_t* GK = (half_t*)(P.ws + WS_GK); half_t* GV = (half_t*)(P.ws + WS_GV); float* GS = (float*)(P.ws + WS_GS);
    const float* cw = P.in[26] + (size_t)i * 4 * 3072; const float* alog = P.in[27] + i * 8; const float* dtb = P.in[28] + i * 8; const float* cst = P.in[6] + (size_t)i * NBS * 3 * 3072;
    for (int row = gw; row < NT; row += ngw) {
        int t, sb; row_info(row, t, sb);
        const half_t* zr = Z + (size_t)row * LDZ_C;
#pragma unroll
        for (int hf = 0; hf < 2; ++hf) {
            const int c = hf * 512 + lane * 8;
            float q[8], k[8], v[8];
            gdn_conv8(zr, cw, cst, t, sb, c, q); gdn_conv8(zr, cw, cst, t, sb, 1024 + c, k); gdn_conv8(zr, cw, cst, t, sb, 2048 + c, v);
            float sq = 0.f, sk = 0.f;
#pragma unroll
            for (int e = 0; e < 8; ++e) { sq += q[e] * q[e]; sk += k[e] * k[e]; }
            sq = red16(sq); sk = red16(sk);
            const float qs = rsqrtf(sq + 1e-6f) * 0.08838834764831845f, kss = rsqrtf(sk + 1e-6f);
            float qk = 0.f; h8 qo, ko, vo;
#pragma unroll
            for (int e = 0; e < 8; ++e) { q[e] *= qs; k[e] *= kss; qk += q[e] * k[e]; qo[e] = (half_t)q[e]; ko[e] = (half_t)k[e]; vo[e] = (half_t)v[e]; }
            qk = red16(qk);
            *(h8*)(GQ + (size_t)row * 1024 + c) = qo; *(h8*)(GK + (size_t)row * 1024 + c) = ko; *(h8*)(GV + (size_t)row * 1024 + c) = vo;
            if ((lane & 15) == 0) {
                const int h = hf * 4 + (lane >> 4);
                const float bl = (float)zr[4096 + h], al = (float)zr[4104 + h];
                const float x = al + dtb[h]; const float sp = x > 20.f ? x : log1pf(__expf(x));
                const float g = -__expf(alog[h]) * sp;
                *(f32x4*)(GS + ((size_t)row * 8 + h) * 4) = (f32x4){sigmoidf_(bl), __expf(g), qk, 0.f};
            }
        }
    }
    for (int q = gw; q < NSEQ * 3; q += ngw) {
        const int s = q / 3, j = q - s * 3;
        const int row = s < NBP ? s * TP + TP - 3 + j : NTP + (s - NBP) * 4 + 1 + j;
        float* dst = s < NBP ? P.out + O_PGDNCONV + (((size_t)i * NBP + s) * 3 + j) * 3072 : P.out + O_SGDNCONV + (((size_t)i * NBS + (s - NBP)) * 3 + j) * 3072;
        for (int p = 0; p < 12; ++p) { const int c = p * 256 + lane * 4; *(f32x4*)(dst + c) = ld_h4(Z + (size_t)row * LDZ_C + c); }
    }
}
struct GdnS { float S[8]; h8 q[4], k[4]; half_t v[4]; f32x4 sc[4]; };
DEVINL void gdn_s_load(const Params& P, int i, int x, int lane, int wave, GdnS& r) {
    const half_t* GQ = (const half_t*)(P.ws + WS_GQ); const half_t* GK = (const half_t*)(P.ws + WS_GK); const half_t* GV = (const half_t*)(P.ws + WS_GV); const float* GS = (const float*)(P.ws + WS_GS);
    const int sb = x >> 5, h = (x >> 2) & 7, g = x & 3, col = g * 32 + wave * 4 + (lane >> 4), ks = lane & 15, row0 = NTP + sb * 4;
    const float* s0 = P.in[5] + (((size_t)i * NBS + sb) * 8 + h) * 16384;
#pragma unroll
    for (int e = 0; e < 8; ++e) r.S[e] = s0[(size_t)(ks * 8 + e) * 128 + col];
#pragma unroll
    for (int u = 0; u < 4; ++u) { const size_t ro = (size_t)(row0 + u) * 1024 + h * 128;
        r.q[u] = *(const h8*)(GQ + ro + ks * 8); r.k[u] = *(const h8*)(GK + ro + ks * 8); r.v[u] = GV[ro + col]; r.sc[u] = *(const f32x4*)(GS + ((size_t)(row0 + u) * 8 + h) * 4); }
}
DEVINL void gdn_s_run(const Params& P, int i, int x, int lane, int wave, GdnS& r) {
    half_t* OD = (half_t*)(P.ws + WS_OD);
    const int sb = x >> 5, h = (x >> 2) & 7, g = x & 3, col = g * 32 + wave * 4 + (lane >> 4), ks = lane & 15, row0 = NTP + sb * 4;
    float* sout = P.out + O_SGDN + (((size_t)i * NBS + sb) * 8 + h) * 16384;
#pragma unroll
    for (int u = 0; u < 4; ++u) {
        float d1 = 0.f, d2 = 0.f;
#pragma unroll
        for (int e = 0; e < 8; ++e) { d1 += r.S[e] * (float)r.k[u][e]; d2 += r.S[e] * (float)r.q[u][e]; }
        d1 = red16(d1); d2 = red16(d2);
        const float beta = r.sc[u][0], eg = r.sc[u][1], qk = r.sc[u][2];
        const float uu = beta * ((float)r.v[u] - eg * d1);
#pragma unroll
        for (int e = 0; e < 8; ++e) r.S[e] = eg * r.S[e] + (float)r.k[u][e] * uu;
        if (ks == 0) OD[(size_t)(row0 + u) * 1024 + h * 128 + col] = (half_t)(eg * d2 + qk * uu);
    }
#pragma unroll
    for (int e = 0; e < 8; ++e) sout[(size_t)(ks * 8 + e) * 128 + col] = r.S[e];
}
DEVINL void phase_scan_c(const Params& P, int i, LAS unsigned char* lds, int tid, int lane, int wave, int G) {
    REP(10) for (int it = blockIdx.x; it < 256; it += G) { const int b = it >> 5, h = (it >> 2) & 7, g = it & 3;
        gdn_item_lds(P, lds, b * TP, TP, h, g, P.out + O_PGDN + (((size_t)i * NBP + b) * 8 + h) * 16384, tid, lane, wave); }
    REP(11) SAMPLE_LOOP(GdnS, gdn_s_load, gdn_s_run, 4096);
}
DEVINL void phase_post_c(const Params& P, int i, int gw, int ngw, int lane) {
    const half_t* Z = (const half_t*)(P.ws + WS_Z); const half_t* OD = (const half_t*)(P.ws + WS_OD); half_t* MO = (half_t*)(P.ws + WS_MO);
    const float* ng = P.in[29] + i * 128;
    const float g0 = ng[lane * 2], g1 = ng[lane * 2 + 1];
    for (int row = gw; row < NT; row += ngw) {
#pragma unroll
        for (int h = 0; h < 8; ++h) {
            const int c = h * 128 + lane * 2;
            const h2 o = *(const h2*)(OD + (size_t)row * 1024 + c); const float o0 = (float)o[0], o1 = (float)o[1];
            const float rs = rsqrtf(wave_sum(o0 * o0 + o1 * o1) * (1.f / 128.f) + 1e-6f);
            const h2 zg = *(const h2*)(Z + (size_t)row * LDZ_C + 3072 + c);
            h2 r; r[0] = (half_t)(o0 * rs * g0 * siluf_((float)zg[0])); r[1] = (half_t)(o1 * rs * g1 * siluf_((float)zg[1]));
            *(h2*)(MO + (size_t)row * D + c) = r;
        }
    }
}

#define GAS __attribute__((address_space(1)))
#define XB_TMO      128
#define XB_XCNT(j)  (256  + 64 * (j))
#define XB_XSUB(j)  (1280 + 64 * (j))
#define XB_XGEN(j)  (2304 + 64 * (j))
#define XB_TOP      3328
#define XB_TOPGEN   3392
#define XCD_BAR_WORDS 3456
#define XB_SPIN_CAP (1u << 18)

__device__ __forceinline__ unsigned xb_ld(unsigned* p)              { return __hip_atomic_load(p, __ATOMIC_RELAXED, __HIP_MEMORY_SCOPE_AGENT); }
__device__ __forceinline__ unsigned xb_add(unsigned* p, unsigned v) { return __hip_atomic_fetch_add(p, v, __ATOMIC_RELAXED, __HIP_MEMORY_SCOPE_AGENT); }
__device__ __forceinline__ unsigned xb_xcc_id() { return (unsigned)__builtin_amdgcn_s_getreg((3 << 11) | 20) & 0xFu; }
#define XB_SPIN(cond, bar) do { unsigned _sp = 0; while (cond) { __builtin_amdgcn_s_sleep(1); \
    if ((++_sp & 255u) == 0u) { if (xb_ld(&(bar)[XB_TMO])) break; if (_sp > XB_SPIN_CAP) { atomicAdd(&(bar)[XB_TMO], 1u); break; } } } } while (0)

struct XcdBarrier {
    unsigned* bar; unsigned x;
    volatile LAS unsigned* st;
};

__device__ __forceinline__ XcdBarrier xcd_barrier_post(unsigned* bar, volatile LAS unsigned* st) {
    XcdBarrier b; b.bar = bar; b.x = xb_xcc_id(); b.st = st;
    if (threadIdx.x == 0) (void)xb_add(&bar[XB_XCNT(b.x)], 1u);
    return b;
}
__device__ __forceinline__ void xcd_barrier_complete(unsigned* bar, unsigned x, unsigned& nloc, unsigned& nx) {
    const unsigned G = gridDim.x * gridDim.y * gridDim.z;
    unsigned sum, cnt, mine, sp = 0u;
    for (;;) {
        sum = 0u; cnt = 0u; mine = 0u;
#pragma unroll
        for (unsigned j = 0; j < 16; ++j) { const unsigned c = xb_ld(&bar[XB_XCNT(j)]); sum += c; cnt += (c > 0u) ? 1u : 0u; mine = (j == x) ? c : mine; }
        if (sum == G) break;
        __builtin_amdgcn_s_sleep(1);
        if ((++sp & 255u) == 0u) { if (xb_ld(&bar[XB_TMO])) break; if (sp > XB_SPIN_CAP) { atomicAdd(&bar[XB_TMO], 1u); break; } }
    }
    nloc = mine > 0u ? mine : 1u; nx = cnt > 0u ? cnt : 1u;
}

__device__ __forceinline__ void xcd_barrier(const XcdBarrier& b) {
    asm volatile("s_waitcnt vmcnt(0)" ::: "memory");
    bar_sync();
    if (threadIdx.x == 0) {
        unsigned* bar = b.bar;
        __builtin_amdgcn_s_waitcnt(0);
        unsigned nloc = b.st[0], nx = b.st[1];
        if (nloc == 0u) { xcd_barrier_complete(bar, b.x, nloc, nx); b.st[0] = nloc; b.st[1] = nx; }
        const unsigned old = xb_add(&bar[XB_XSUB(b.x)], 1u);
        const unsigned gen = old / nloc;
        if (old + 1u == (gen + 1u) * nloc) {
            __builtin_amdgcn_fence(__ATOMIC_RELEASE, "agent");
            asm volatile("s_waitcnt vmcnt(0)" ::: "memory");
            const unsigned og = xb_add(&bar[XB_TOP], 1u);
            const unsigned tg = og / nx;
            if (og + 1u == (tg + 1u) * nx) xb_add(&bar[XB_TOPGEN], 1u);
            else XB_SPIN(xb_ld(&bar[XB_TOPGEN]) == tg, bar);
            __builtin_amdgcn_fence(__ATOMIC_ACQUIRE, "agent");
            xb_add(&bar[XB_XGEN(b.x)], 1u);
            asm volatile("s_waitcnt vmcnt(0)" ::: "memory");
        } else {
            XB_SPIN(xb_ld(&bar[XB_XGEN(b.x)]) == gen, bar);
            __builtin_amdgcn_fence(__ATOMIC_ACQUIRE, "agent");
            asm volatile("s_waitcnt vmcnt(0)" ::: "memory");
        }
    }
    bar_sync();
}


constexpr int N_PHASES = 41;
#if defined(__HIP_DEVICE_COMPILE__)
#define NO_PK_F32 __attribute__((target("no-packed-fp32-ops")))
#else
#define NO_PK_F32
#endif
__global__ void __launch_bounds__(NTHREADS, 2) NO_PK_F32 mega_fwd(Params P) {
    extern __shared__ __attribute__((aligned(16))) unsigned char lds_raw[];
    LAS unsigned char* lds = (LAS unsigned char*)lds_raw;
#if !MK_MULTI
    cg::grid_group grid = cg::this_grid();
    volatile LAS unsigned* bar_st = (volatile LAS unsigned*)(lds + 132096);
    if (threadIdx.x < 2) bar_st[threadIdx.x] = 0u;
    bar_sync();
    const XcdBarrier gbar = xcd_barrier_post((unsigned*)(P.ws + 4096), bar_st);
#define SEAM(k) do { if ((k) + 1 < N_PHASES) { if ((k) == 0) grid.sync(); else xcd_barrier(gbar); } } while (0)
#else
#define SEAM(k) do { } while (0)
#endif
#if MK_MULTI
#define IN(k) (P.ph_lo <= (k) && (k) < P.ph_hi)
#else
#define IN(k) true
#endif
#define PHASE_LOCALS() int tid = threadIdx.x, bid = blockIdx.x, G = gridDim.x; asm volatile("" : "+v"(tid), "+s"(bid), "+s"(G)); (void)bid; \
    const int lane = tid & 63, wave = __builtin_amdgcn_readfirstlane(tid >> 6), gw = bid * NWAVES + wave, ngw = G * NWAVES; (void)lane; (void)gw; (void)ngw;
    { PHASE_LOCALS();
      if (IN(0)) { phase_prologue(P, gw, ngw, lane); convert_layer_weights(P, 0, lds, gw, ngw, lane, wave); SEAM(0); } }
#pragma unroll 1
    for (int l = 0; l < 4; ++l) {
        const int base = 1 + l * 10, i = l >> 1; const bool even = (l & 1) == 0;
        const int ldz = even ? LDZ_AB : LDZ_C;
        { PHASE_LOCALS();
        if (IN(base + 0)) {
            pg8::Gemm g{(half_t*)(P.ws + WS_XB), (half_t*)(P.ws + WS_WIN), MP, ldz, D}; pg8::StaticOrder S; S.init(MP, ldz, G, bid);
            pg8::EpiZ E{(half_t*)(P.ws + WS_Z), ldz};
            REP(0) pg8::gemm_phase<pg8::EpiZ, pg8::StaticOrder, true, true>(lds, g, S, E, tid);
            SEAM(base + 0);
        } }
        { PHASE_LOCALS(); if (IN(base + 1)) { REP(1) if (even) phase_prep_ab(P, i, lds, tid, lane, wave, G); else phase_prep_c(P, i, gw, ngw, lane); SEAM(base + 1); } }
        { PHASE_LOCALS(); if (IN(base + 2)) { REP(2) if (even) phase_scan_ab(P, i, lds, tid, lane, wave, G); else phase_scan_c(P, i, lds, tid, lane, wave, G); SEAM(base + 2); } }
        { PHASE_LOCALS(); if (IN(base + 3)) { REP(3) if (even) phase_post_ab(P, i, gw, ngw, lane); else phase_post_c(P, i, gw, ngw, lane); SEAM(base + 3); } }
        { PHASE_LOCALS();
        if (IN(base + 4)) {
            pg8::Gemm g{(half_t*)(P.ws + WS_MO), (half_t*)(P.ws + WS_WOUT), MP, D, D};
            pg8::EpiRes E{(float*)(P.ws + WS_X), ALPHA, (float*)(P.ws + WS_XACC)};
            pg8::SplitOrder S; S.init(D, G, bid);
            pg8::gemm_phase<pg8::EpiRes, pg8::SplitOrder, true, true>(lds, g, S, E, tid);
            SEAM(base + 4);
        } }
        { PHASE_LOCALS(); if (IN(base + 5)) { if ((PROBE_MASK >> 5) & 1) phase_ln(P, P.in[35] + l * D, P.in[36] + l * D, false, -1, 8, gw, ngw, lane, true); phase_ln(P, P.in[35] + l * D, P.in[36] + l * D, false, -1, 8, gw, ngw, lane); SEAM(base + 5); } }
        { PHASE_LOCALS();
        if (IN(base + 6)) {
            pg8::Gemm g{(half_t*)(P.ws + WS_XB), (half_t*)(P.ws + WS_WUP), MP, LDH, D}; pg8::StaticOrder S; S.init(MP, LDH, G, bid);
            pg8::EpiZ E{(half_t*)(P.ws + WS_Z), LDH};
            REP(6) pg8::gemm_phase<pg8::EpiZ, pg8::StaticOrder, true, true>(lds, g, S, E, tid);
            SEAM(base + 6);
        } }
        { PHASE_LOCALS(); if (IN(base + 7)) { REP(7) phase_act(P, l, gw, ngw, lane); SEAM(base + 7); } }
        { PHASE_LOCALS();
        if (IN(base + 8)) {
            pg8::Gemm g{(half_t*)(P.ws + WS_MO), (half_t*)(P.ws + WS_WDN), MP, D, DFF};
            pg8::EpiRes E{(float*)(P.ws + WS_X), ALPHA, (float*)(P.ws + WS_XACC)};
            pg8::SplitOrder S; S.init(DFF, G, bid);
            pg8::gemm_phase<pg8::EpiRes, pg8::SplitOrder, true, true>(lds, g, S, E, tid);
            SEAM(base + 8);
        } }
        { PHASE_LOCALS();
        if (IN(base + 9)) {
            phase_ln(P, P.in[37] + l * D, P.in[38] + l * D, l == 3, l == 1 ? 1 : -1, 11, gw, ngw, lane);
            if (l < 3) convert_layer_weights(P, l + 1, lds, gw, ngw, lane, wave);
            SEAM(base + 9);
        } }
    }
#undef IN
#undef SEAM
}

extern "C" void kernel_launch(void* const* d_in, const int* in_sizes, int n_in, void* d_out, int out_size, void* d_ws, size_t ws_size, hipStream_t stream) {
    static int grid = 0;
    if (grid == 0) {
        if (n_in != 39 || (size_t)out_size != O_END || ws_size < WS_END) { fprintf(stderr, "kernel_launch: unexpected problem (n_in %d, out %d, ws %zu); nothing launched\n", n_in, out_size, ws_size); grid = -1; return; }
        int dev = 0, cus = 0, per_cu = 0;
        if (hipGetDevice(&dev) != hipSuccess || hipDeviceGetAttribute(&cus, hipDeviceAttributeMultiprocessorCount, dev) != hipSuccess) { grid = -1; return; }
        if (hipFuncSetAttribute((const void*)mega_fwd, hipFuncAttributeMaxDynamicSharedMemorySize, LDS_BYTES) != hipSuccess) { fprintf(stderr, "kernel_launch: hipFuncSetAttribute failed\n"); grid = -1; return; }
        if (hipOccupancyMaxActiveBlocksPerMultiprocessor(&per_cu, (const void*)mega_fwd, NTHREADS, LDS_BYTES) != hipSuccess || per_cu < 1) { fprintf(stderr, "kernel_launch: occupancy query says %d blocks per CU\n", per_cu); (void)hipGetLastError(); grid = -1; return; }
        if (cus != 256) { fprintf(stderr, "kernel_launch: built for a 256-CU device (got %d)\n", cus); grid = -1; return; }
        grid = cus;
    }
    if (grid < 0) return;
    if (hipMemsetAsync(d_ws, 0, 65536, stream) != hipSuccess) { fprintf(stderr, "kernel_launch: hipMemsetAsync failed\n"); return; }
    Params p{};
    for (int k = 0; k < 39; ++k) p.in[k] = (const float*)d_in[k];
    p.out = (float*)d_out; p.ws = (unsigned char*)d_ws;
#if MK_MULTI
    for (int k = 0; k < N_PHASES; ++k) { p.ph_lo = k; p.ph_hi = k + 1; hipLaunchKernelGGL(mega_fwd, dim3(grid), dim3(NTHREADS), LDS_BYTES, stream, p); }
#else
    p.ph_lo = 0; p.ph_hi = N_PHASES;
    void* args[] = {&p};
    const hipError_t e = hipLaunchCooperativeKernel((const void*)mega_fwd, dim3(grid), dim3(NTHREADS), args, LDS_BYTES, stream);
    if (e != hipSuccess) fprintf(stderr, "kernel_launch: cooperative launch failed: %s (grid %d)\n", hipGetErrorString(e), grid);
#endif
}
```
